# Optimizing an MI355X kernel written in HIP

```python
import math
import jax, jax.numpy as jnp
from jax import lax
import numpy as np

D_MODEL = 2048
BATCH = 8
SEQ = 4096
DEPTH = 1
DEC_BATCH = 2
DEC_SEQ = 4096
PAST_LEN = 128

MLA_HEADS = 8
MLA_NOPE = 128
MLA_ROPE = 64
MLA_V = 128
Q_LORA = 512
KV_LORA = 256
GQA_HEADS = 8
GQA_KV_HEADS = 2
GQA_HEAD_DIM = 128
MEM_HEADS = 4
MEM_HEAD_DIM = 256
MEM_TOKENS = 256
BRANCH_W = 1024
N_BRANCH = 3
GRID_W = 64
BLOCK_Q = 128
ROPE_BASE = 10000.0
EPS = 1e-6

kernel_name = "hybrid_mla_gqa_mem_gated_encoder"


def _in_sizes():
    return [Q_LORA, KV_LORA, MLA_ROPE,
            GQA_HEADS * GQA_HEAD_DIM, GQA_KV_HEADS * GQA_HEAD_DIM, GQA_KV_HEADS * GQA_HEAD_DIM,
            MEM_HEADS * MEM_HEAD_DIM,
            N_BRANCH * BRANCH_W,
            N_BRANCH * D_MODEL]


def rmsnorm(x, g):
    xf = x.astype(jnp.float32)
    xf = xf * lax.rsqrt(jnp.mean(xf * xf, axis=-1, keepdims=True) + EPS)
    return xf.astype(x.dtype) * g


def grid_positions(s):
    rows = s // GRID_W
    row = jnp.repeat(jnp.arange(rows, dtype=jnp.float32), GRID_W)
    col = jnp.tile(jnp.arange(GRID_W, dtype=jnp.float32), rows)
    return row, col


def rope_1d(x, pos):
    half = x.shape[-1] // 2
    freqs = ROPE_BASE ** (-jnp.arange(half, dtype=jnp.float32) / half)
    ang = pos[:, None] * freqs[None, :]
    cos = jnp.cos(ang)[:, None, :].astype(x.dtype)
    sin = jnp.sin(ang)[:, None, :].astype(x.dtype)
    x1, x2 = x[..., :half], x[..., half:]
    return jnp.concatenate([x1 * cos - x2 * sin, x2 * cos + x1 * sin], axis=-1)


def axial_rope(x, row, col):
    d = x.shape[-1] // 2
    return jnp.concatenate([rope_1d(x[..., :d], row), rope_1d(x[..., d:], col)], axis=-1)


def block_attention(q, k, v, scale):
    b, s, g, r, dk = q.shape
    nb = s // BLOCK_Q
    qb = q.reshape(b, nb, BLOCK_Q, g, r, dk).transpose(1, 0, 2, 3, 4, 5)

    def one(qblk):
        sc = jnp.einsum('bqgrd,bkgd->bgrqk', qblk, k).astype(jnp.float32) * scale
        p = jax.nn.softmax(sc, axis=-1).astype(v.dtype)
        return jnp.einsum('bgrqk,bkgv->bqgrv', p, v)

    out = lax.map(one, qb)
    dv = v.shape[-1]
    return out.transpose(1, 0, 2, 3, 4, 5).reshape(b, s, g * r, dv)


def layer(x, mem, row, col, norm_g, w_in, mla_q_norm_g, w_q_b, mla_kv_norm_g, w_kv_b,
          gqa_q_norm_g, gqa_k_norm_g, mem_norm_g, w_mem_kv, w_branch, w_out):
    b, s, _ = x.shape
    h = rmsnorm(x, norm_g)
    proj = h @ w_in
    idx = np.cumsum(_in_sizes())[:-1].tolist()
    cq, ckv, kpe, qg, kg, vg, qm, z, gl = jnp.split(proj, idx, axis=-1)

    cq = rmsnorm(cq, mla_q_norm_g)
    q = (cq @ w_q_b).reshape(b, s, MLA_HEADS, MLA_NOPE + MLA_ROPE)
    q_nope, q_pe = q[..., :MLA_NOPE], q[..., MLA_NOPE:]
    q_pe = axial_rope(q_pe, row, col)
    ckv = rmsnorm(ckv, mla_kv_norm_g)
    kv = (ckv @ w_kv_b).reshape(b, s, MLA_HEADS, MLA_NOPE + MLA_V)
    k_nope, v_mla = kv[..., :MLA_NOPE], kv[..., MLA_NOPE:]
    k_pe = axial_rope(kpe[:, :, None, :], row, col)
    k_pe = jnp.broadcast_to(k_pe, (b, s, MLA_HEADS, MLA_ROPE))
    q_full = jnp.concatenate([q_nope, q_pe], axis=-1)[:, :, :, None, :]
    k_full = jnp.concatenate([k_nope, k_pe], axis=-1)
    o_mla = block_attention(q_full, k_full, v_mla, 1.0 / math.sqrt(MLA_NOPE + MLA_ROPE))
    o_mla = o_mla.reshape(b, s, BRANCH_W)

    qg = rmsnorm(qg.reshape(b, s, GQA_HEADS, GQA_HEAD_DIM), gqa_q_norm_g)
    kg = rmsnorm(kg.reshape(b, s, GQA_KV_HEADS, GQA_HEAD_DIM), gqa_k_norm_g)
    vg = vg.reshape(b, s, GQA_KV_HEADS, GQA_HEAD_DIM)
    qg = axial_rope(qg, row, col).reshape(b, s, GQA_KV_HEADS, GQA_HEADS // GQA_KV_HEADS, GQA_HEAD_DIM)
    kg = axial_rope(kg, row, col)
    o_gqa = block_attention(qg, kg, vg, 1.0 / math.sqrt(GQA_HEAD_DIM)).reshape(b, s, BRANCH_W)

    m = rmsnorm(mem, mem_norm_g)
    mkv = (m @ w_mem_kv).reshape(b, MEM_TOKENS, 2, MEM_HEADS, MEM_HEAD_DIM)
    km, vm = mkv[:, :, 0], mkv[:, :, 1]
    qm = qm.reshape(b, s, MEM_HEADS, MEM_HEAD_DIM)
    sc = jnp.einsum('bshd,bmhd->bhsm', qm, km).astype(jnp.float32) * (1.0 / math.sqrt(MEM_HEAD_DIM))
    pm = jax.nn.softmax(sc, axis=-1).astype(vm.dtype)
    o_mem = jnp.einsum('bhsm,bmhd->bshd', pm, vm).reshape(b, s, BRANCH_W)

    z = z.reshape(b, s, N_BRANCH, BRANCH_W)
    gl = gl.reshape(b, s, N_BRANCH, D_MODEL)
    merged = None
    for i, o in enumerate((o_mla, o_gqa, o_mem)):
        term = jax.nn.sigmoid(gl[:, :, i]) * ((o * jax.nn.silu(z[:, :, i])) @ w_branch[i])
        merged = term if merged is None else merged + term
    return x + merged @ w_out


def trunk(x, mem, norm_g, w_in, mla_q_norm_g, w_q_b, mla_kv_norm_g, w_kv_b,
          gqa_q_norm_g, gqa_k_norm_g, mem_norm_g, w_mem_kv, w_branch, w_out, final_norm_g):
    row, col = grid_positions(x.shape[1])
    h = x
    for l in range(DEPTH):
        h = layer(h, mem, row, col, norm_g[l], w_in[l], mla_q_norm_g[l], w_q_b[l], mla_kv_norm_g[l],
                  w_kv_b[l], gqa_q_norm_g[l], gqa_k_norm_g[l], mem_norm_g[l], w_mem_kv[l],
                  w_branch[l], w_out[l])
    return rmsnorm(h, final_norm_g)


def setup_inputs(seed: int = 0) -> dict:
    key = jax.random.key(seed)
    ks = jax.random.split(key, 20)
    f32 = jnp.float32
    in_cols = int(sum(_in_sizes()))

    def w(k, shape, fan_in):
        return jax.random.normal(k, shape, f32) * (fan_in ** -0.5)

    def gain(k, shape):
        return 1.0 + 0.02 * jax.random.normal(k, shape, f32)

    return {
        "x_prompt": jax.random.normal(ks[0], (BATCH, SEQ, D_MODEL), f32),
        "x_sample": jax.random.normal(ks[1], (DEC_BATCH, DEC_SEQ, D_MODEL), f32),
        "mem_prompt": jax.random.normal(ks[2], (BATCH, MEM_TOKENS, D_MODEL), f32),
        "mem_sample": jax.random.normal(ks[3], (DEC_BATCH, MEM_TOKENS, D_MODEL), f32),
        "norm_g": gain(ks[4], (DEPTH, D_MODEL)),
        "w_in": w(ks[5], (DEPTH, D_MODEL, in_cols), D_MODEL),
        "mla_q_norm_g": gain(ks[6], (DEPTH, Q_LORA)),
        "w_q_b": w(ks[7], (DEPTH, Q_LORA, MLA_HEADS * (MLA_NOPE + MLA_ROPE)), Q_LORA),
        "mla_kv_norm_g": gain(ks[8], (DEPTH, KV_LORA)),
        "w_kv_b": w(ks[9], (DEPTH, KV_LORA, MLA_HEADS * (MLA_NOPE + MLA_V)), KV_LORA),
        "gqa_q_norm_g": gain(ks[10], (DEPTH, GQA_HEAD_DIM)),
        "gqa_k_norm_g": gain(ks[11], (DEPTH, GQA_HEAD_DIM)),
        "mem_norm_g": gain(ks[12], (DEPTH, D_MODEL)),
        "w_mem_kv": w(ks[13], (DEPTH, D_MODEL, 2 * MEM_HEADS * MEM_HEAD_DIM), D_MODEL),
        "w_branch": w(ks[14], (DEPTH, N_BRANCH, BRANCH_W, D_MODEL), BRANCH_W),
        "w_out": w(ks[15], (DEPTH, D_MODEL, D_MODEL), D_MODEL),
        "final_norm_g": gain(ks[16], (D_MODEL,)),
    }


def reference(x_prompt, x_sample, mem_prompt, mem_sample, norm_g, w_in, mla_q_norm_g, w_q_b,
              mla_kv_norm_g, w_kv_b, gqa_q_norm_g, gqa_k_norm_g, mem_norm_g, w_mem_kv,
              w_branch, w_out, final_norm_g):
    y_prompt = trunk(x_prompt, mem_prompt, norm_g, w_in, mla_q_norm_g, w_q_b, mla_kv_norm_g, w_kv_b,
                     gqa_q_norm_g, gqa_k_norm_g, mem_norm_g, w_mem_kv, w_branch, w_out, final_norm_g)
    y_sample = trunk(x_sample, mem_sample, norm_g, w_in, mla_q_norm_g, w_q_b, mla_kv_norm_g, w_kv_b,
                     gqa_q_norm_g, gqa_k_norm_g, mem_norm_g, w_mem_kv, w_branch, w_out, final_norm_g)
    return (y_prompt, y_sample)
```

```cpp
#include <hip/hip_runtime.h>
#include <hip/hip_cooperative_groups.h>
#include <cstdio>
#include <cstdint>
namespace cg = cooperative_groups;

#define PROBE_BETA 1.0f
#ifndef MK_COOP
#define MK_COOP 1
#endif

#define LAS __attribute__((address_space(3)))
typedef unsigned short bf16_t;
typedef short bf16x8 __attribute__((ext_vector_type(8)));
typedef short s16x4 __attribute__((ext_vector_type(4)));
typedef float f32x2 __attribute__((ext_vector_type(2)));
typedef float f32x4 __attribute__((ext_vector_type(4)));
typedef float f32x16 __attribute__((ext_vector_type(16)));
typedef unsigned u32x2 __attribute__((ext_vector_type(2)));
typedef unsigned u32x4 __attribute__((ext_vector_type(4)));
typedef long l64x2 __attribute__((ext_vector_type(2)));

constexpr int T = 40960, TP = 32768, DM = 2048, SEQ = 4096, NBATCH = 10, MEMROWS = 2560;
constexpr float EPS = 1e-6f;
constexpr int NP1 = 6656;
constexpr size_t WS_WIN = 0;
constexpr size_t WS_WGL = WS_WIN + (size_t)NP1 * 2048 * 2;
constexpr size_t WS_WQB = WS_WGL + (size_t)6144 * 2048 * 2;
constexpr size_t WS_WKVB = WS_WQB + (size_t)1536 * 512 * 2;
constexpr size_t WS_WMKV = WS_WKVB + (size_t)2048 * 256 * 2;
constexpr size_t WS_WBR = WS_WMKV + (size_t)2048 * 2048 * 2;
constexpr size_t WS_WOUT = WS_WBR + (size_t)3 * 2048 * 1024 * 2;
constexpr size_t WS_TABG = WS_WOUT + (size_t)2048 * 2048 * 2;
constexpr size_t WS_TABM = WS_TABG + 64 * 32 * 8;
constexpr size_t WS_GQP = WS_TABM + 64 * 16 * 8;
constexpr size_t WS_GKP = WS_GQP + 512;
constexpr size_t WS_BAR = WS_GKP + 512;
constexpr size_t WS_ZERO = WS_BAR + 256;
constexpr size_t WS_SSQ = WS_ZERO + 4096 * 64 * 2;
constexpr size_t WS_Z = WS_SSQ + (size_t)T * 32 * 4;
constexpr size_t WS_R = WS_Z + (size_t)T * 3072 * 2;
constexpr size_t WS_CQ = WS_R;
constexpr size_t WS_CKV = WS_CQ + (size_t)T * 512 * 2;
constexpr size_t WS_KPE = WS_CKV + (size_t)T * 256 * 2;
constexpr size_t WS_QG = WS_KPE + (size_t)T * 64 * 2;
constexpr size_t WS_KG = WS_QG + (size_t)T * 1024 * 2;
constexpr size_t WS_VG = WS_KG + (size_t)T * 256 * 2;
constexpr size_t WS_QM = WS_VG + (size_t)T * 256 * 2;
constexpr size_t WS_KN = WS_QM + (size_t)T * 1024 * 2;
constexpr size_t WS_VN = WS_KN + (size_t)T * 1024 * 2;
constexpr size_t WS_KM = WS_VN + (size_t)T * 1024 * 2;
constexpr size_t WS_VM = WS_KM + (size_t)MEMROWS * 1024 * 2;
constexpr size_t WS_VMT = WS_VM + (size_t)MEMROWS * 1024 * 2;
constexpr size_t WS_REND = WS_VMT + (size_t)MEMROWS * 1024 * 2;
constexpr size_t WS_GL = WS_R;
constexpr size_t WS_MERGED = WS_GL + (size_t)T * 6144 * 2;
constexpr size_t WS_END = WS_MERGED + (size_t)T * 2048 * 2;
constexpr size_t WS_H8 = WS_MERGED;
constexpr float H8_SCALE = 16.f, W8_SCALE = 64.f;
static_assert(WS_REND <= WS_MERGED, "region R inside GL overlay");
static_assert(WS_END <= (size_t)1 << 30, "d_ws map fits 1 GiB");
constexpr size_t DO_H = 0;
constexpr size_t DO_QMLA = DO_H + (size_t)T * 2048 * 2;
constexpr size_t DO_MN = DO_QMLA + (size_t)T * 1536 * 2;
static_assert(DO_MN + (size_t)MEMROWS * 2048 * 2 <= (size_t)T * 2048 * 4, "d_out scratch");

constexpr int LDS_BYTES = 131072 + 512;

typedef float f32x2_cv __attribute__((ext_vector_type(2)));
typedef __bf16 bf16x2_cv __attribute__((ext_vector_type(2)));
__device__ __forceinline__ unsigned cvt_pk_bf16(float lo, float hi) { unsigned r; asm volatile("v_cvt_pk_bf16_f32 %0, %1, %2" : "=v"(r) : "v"(lo), "v"(hi)); return r; }
__device__ __forceinline__ unsigned cvt_pk_bf16_safe(float lo, float hi) { const f32x2_cv v = {lo, hi}; const bf16x2_cv b = __builtin_convertvector(v, bf16x2_cv); return __builtin_bit_cast(unsigned, b); }
__device__ __forceinline__ u32x4 ld16_coherent(const void* p) { u32x4 v; asm volatile("global_load_dwordx4 %0, %1, off sc1\n\ts_waitcnt vmcnt(0)" : "=v"(v) : "v"(p) : "memory"); return v; }
__device__ __forceinline__ float bf_lo(unsigned w) { return __uint_as_float(w << 16); }
__device__ __forceinline__ float bf_hi(unsigned w) { return __uint_as_float(w & 0xffff0000u); }
__device__ __forceinline__ float wave_sum(float v) {
#pragma unroll
    for (int o = 1; o < 64; o <<= 1) v += __shfl_xor(v, o);
    return v;
}
__device__ __forceinline__ float fast_sigmoid(float v) { return __builtin_amdgcn_rcpf(1.f + __builtin_amdgcn_exp2f(-1.4426950408889634f * v)); }
__device__ __forceinline__ float fast_silu(float v) { return v * fast_sigmoid(v); }

namespace pg8 {
constexpr int BM = 256, BK = 64, HALF = 128, HTB = HALF * BK * 2, STAGE_BYTES = 8 * HTB, NXCD = 8, WGM = 8;
__host__ __device__ __forceinline__ int lds_byte(int r, int c) { const int st = (r >> 4) * 2 + (c >> 5), rr = r & 15, cc = c & 31, ob = rr * 64 + cc * 2; return st * 1024 + (ob ^ (((ob >> 9) & 1) << 5)); }
__host__ __device__ __forceinline__ void stage_rc(int b, int& R, int& C) { const int st = b / 1024, sb = b % 1024, swz = sb ^ (((sb >> 9) & 1) << 5); R = (st >> 1) * 16 + swz / 64; C = (st & 1) * 32 + (swz % 64) / 2; }
__host__ __device__ __forceinline__ int perm32(int rho) { const int n = rho >> 4, i = rho & 15; return 8 * (i >> 2) + 4 * n + (i & 3); }

struct Unit { int pm, pn; };
struct Gemm { const bf16_t* A; const bf16_t* Bt; int lda, ldb, M, N, K; };

struct StaticOrder {
    int nM, nN, nwg, G, c;
    __device__ void init(int M, int N, int G_, int c_) { nM = M / BM; nN = N / BM; nwg = nM * nN; G = G_; c = c_; }
    __device__ bool next(int i, Unit& u) const {
        const long L = (long)i * G + c; if (L >= nwg) return false;
        int wgid = (int)L; { const int q = nwg / NXCD, r = nwg % NXCD, xcd = wgid % NXCD, off = wgid / NXCD; wgid = (xcd < r ? xcd * (q + 1) : r * (q + 1) + (xcd - r) * q) + off; }
        const int nig = WGM * nN, gid = wgid / nig, fm = gid * WGM, gsz = (nM - fm) < WGM ? (nM - fm) : WGM;
        u.pm = fm + ((wgid % nig) % gsz); u.pn = (wgid % nig) / gsz; return true;
    }
};

template <class Epi, class Sched, bool FP8 = false>
__device__ __forceinline__ void gemm_phase(LAS unsigned char* lds, const Gemm g, const Sched& S, const Epi& E) {
    const int tid = threadIdx.x, wid = __builtin_amdgcn_readfirstlane(tid >> 6), lane = tid & 63, wr = wid >> 2, wc = wid & 3, fr = lane & 15, fq = lane >> 4;
    const int K = g.K, nt = K / BK;
    unsigned voffA[2], voffB[2];
#pragma unroll
    for (int i = 0; i < 2; ++i) { int R, C; stage_rc(tid * 16 + i * 8192, R, C); const int Rb = Epi::PERM ? ((R & ~31) + perm32(R & 31)) : R;
        voffA[i] = (unsigned)(R * g.lda + C) * 2u; voffB[i] = (unsigned)(Rb * g.ldb + C) * 2u; }
    const size_t kstep = (size_t)(BK * 2);
    const size_t hstepA = (size_t)HALF * g.lda * 2, hstepB = (size_t)HALF * g.ldb * 2;
    const size_t tstepA = 2 * hstepA, tstepB = 2 * hstepB;
    const unsigned ldsw = (unsigned)wid * 1024u;
    const int aoff = lds_byte(wr * 64 + fr, fq * 8), boff = lds_byte(wc * 32 + fr, fq * 8);
#define PG8_SA(b, h) (((b) * 2 + (h)) * HTB)
#define PG8_SB(b, h) ((4 + (b) * 2 + (h)) * HTB)
#define PG8_STAGE(bufoff, gbase, voff) do { _Pragma("unroll") for (int _i = 0; _i < 2; ++_i) \
        __builtin_amdgcn_global_load_lds((const unsigned*)((const char*)(gbase) + (voff)[_i]), (LAS unsigned*)(lds + (bufoff) + ldsw + _i * 8192), 16, 0, 0); } while (0)
#define PG8_LDA(dst, b, h) do { _Pragma("unroll") for (int m = 0; m < 4; ++m) _Pragma("unroll") for (int k = 0; k < 2; ++k) dst[m][k] = *(const LAS bf16x8*)(lds + PG8_SA(b, h) + aoff + m * 2048 + k * 1024); } while (0)
#define PG8_LDB(dst, b, h) do { _Pragma("unroll") for (int n = 0; n < 2; ++n) _Pragma("unroll") for (int k = 0; k < 2; ++k) dst[n][k] = *(const LAS bf16x8*)(lds + PG8_SB(b, h) + boff + n * 2048 + k * 1024); } while (0)
#define PG8_MMA(ai, bj, At, Bt) do { __builtin_amdgcn_s_setprio(1); _Pragma("unroll") for (int m = 0; m < 4; ++m) _Pragma("unroll") for (int n = 0; n < 2; ++n) _Pragma("unroll") for (int k = 0; k < 2; ++k) { \
        if constexpr (FP8) { const l64x2 b_ = __builtin_bit_cast(l64x2, Bt[n][k]), a_ = __builtin_bit_cast(l64x2, At[m][k]); \
            acc[ai][bj][m][n] = __builtin_amdgcn_mfma_f32_16x16x32_fp8_fp8(b_[0], a_[0], acc[ai][bj][m][n], 0, 0, 0); \
            acc[ai][bj][m][n] = __builtin_amdgcn_mfma_f32_16x16x32_fp8_fp8(b_[1], a_[1], acc[ai][bj][m][n], 0, 0, 0); } \
        else acc[ai][bj][m][n] = __builtin_amdgcn_mfma_f32_16x16x32_bf16(Bt[n][k], At[m][k], acc[ai][bj][m][n], 0, 0, 0); } __builtin_amdgcn_s_setprio(0); } while (0)
#define PG8_WAIT_V(n) asm volatile("s_waitcnt vmcnt(" #n ")" ::: "memory")
#define PG8_WAIT_L(n) asm volatile("s_waitcnt lgkmcnt(" #n ")" ::: "memory")
#define PG8_BAR __builtin_amdgcn_s_barrier()
#define PG8_SCHED __builtin_amdgcn_sched_barrier(0)
    Unit cur, nxt; int ui = 0;
    if (!S.next(0, cur)) return;
    f32x4 acc[2][2][4][2];
#pragma unroll
    for (int a = 0; a < 2; ++a)
#pragma unroll
        for (int b = 0; b < 2; ++b)
#pragma unroll
            for (int m = 0; m < 4; ++m)
#pragma unroll
                for (int n = 0; n < 2; ++n) acc[a][b][m][n] = (f32x4){0.f, 0.f, 0.f, 0.f};
    bf16x8 At[4][2], B0[2][2], B1[2][2];
    const char* cA = (const char*)g.A + (size_t)cur.pm * tstepA; const char* cB = (const char*)g.Bt + (size_t)cur.pn * tstepB;
    PG8_STAGE(PG8_SB(0, 0), cB, voffB); PG8_STAGE(PG8_SB(0, 1), cB + hstepB, voffB); PG8_STAGE(PG8_SA(0, 0), cA, voffA); PG8_STAGE(PG8_SA(0, 1), cA + hstepA, voffA);
    if (wr == 1) PG8_BAR;
    PG8_WAIT_V(2); PG8_BAR;
    PG8_STAGE(PG8_SB(1, 0), cB + kstep, voffB); PG8_STAGE(PG8_SA(1, 0), cA + kstep, voffA); PG8_STAGE(PG8_SB(1, 1), cB + hstepB + kstep, voffB);
    PG8_WAIT_V(6); PG8_BAR;
    for (;;) {
        const bool has_next = S.next(ui + 1, nxt);
        const char* nA = has_next ? (const char*)g.A + (size_t)nxt.pm * tstepA : cA; const char* nB = has_next ? (const char*)g.Bt + (size_t)nxt.pn * tstepB : cB;
        for (int t = 0; t < nt; t += 2) {
            const bool last = (t == nt - 2);
            const char* a1 = cA + (size_t)(t + 1) * kstep;
            const char* a2 = last ? nA : cA + (size_t)(t + 2) * kstep; const char* b2 = last ? nB : cB + (size_t)(t + 2) * kstep;
            const char* a3 = a2 + kstep; const char* b3 = b2 + kstep;
            PG8_LDB(B0, 0, 0); PG8_LDB(B1, 0, 1); PG8_SCHED; PG8_LDA(At, 0, 0); PG8_STAGE(PG8_SA(1, 1), a1 + hstepA, voffA);
            PG8_WAIT_V(8); PG8_WAIT_L(0); PG8_BAR; PG8_MMA(0, 0, At, B0); PG8_MMA(0, 1, At, B1); PG8_BAR; PG8_SCHED;
            PG8_LDA(At, 0, 1); PG8_STAGE(PG8_SB(0, 0), b2, voffB); PG8_STAGE(PG8_SB(0, 1), b2 + hstepB, voffB); PG8_STAGE(PG8_SA(0, 0), a2, voffA);
            PG8_WAIT_V(8); PG8_WAIT_L(0); PG8_BAR; PG8_MMA(1, 0, At, B0); PG8_MMA(1, 1, At, B1); PG8_BAR; PG8_SCHED;
            PG8_LDB(B0, 1, 0); PG8_LDB(B1, 1, 1); PG8_SCHED; PG8_LDA(At, 1, 0); PG8_STAGE(PG8_SA(0, 1), a2 + hstepA, voffA);
            PG8_WAIT_V(8); PG8_WAIT_L(0); PG8_BAR; PG8_MMA(0, 0, At, B0); PG8_MMA(0, 1, At, B1); PG8_BAR; PG8_SCHED;
            PG8_LDA(At, 1, 1); PG8_STAGE(PG8_SB(1, 0), b3, voffB); PG8_STAGE(PG8_SB(1, 1), b3 + hstepB, voffB); PG8_STAGE(PG8_SA(1, 0), a3, voffA);
            PG8_WAIT_V(8); PG8_WAIT_L(0); PG8_BAR; PG8_MMA(1, 0, At, B0); PG8_MMA(1, 1, At, B1); PG8_BAR; PG8_SCHED;
        }
        if (wr == 0) PG8_BAR;
        E(acc, cur, wr, wc, fr, fq);
        if (!has_next) break;
#pragma unroll
        for (int a = 0; a < 2; ++a)
#pragma unroll
            for (int b = 0; b < 2; ++b)
#pragma unroll
                for (int m = 0; m < 4; ++m)
#pragma unroll
                    for (int n = 0; n < 2; ++n) acc[a][b][m][n] = (f32x4){0.f, 0.f, 0.f, 0.f};
        cur = nxt; cA = nA; cB = nB; ++ui;
        if (wr == 1) PG8_BAR;
    }
    PG8_WAIT_V(0);
    PG8_BAR;
#undef PG8_SA
#undef PG8_SB
#undef PG8_STAGE
#undef PG8_LDA
#undef PG8_LDB
#undef PG8_MMA
#undef PG8_WAIT_V
#undef PG8_WAIT_L
#undef PG8_BAR
#undef PG8_SCHED
}

template <class F> __device__ __forceinline__ void epi_loop(const f32x4 (&acc)[2][2][4][2], const Unit& u, int wr, int wc, int fr, int fq, F f) {
#pragma unroll
    for (int ai = 0; ai < 2; ++ai)
#pragma unroll
        for (int m = 0; m < 4; ++m) { const int row = u.pm * BM + ai * HALF + wr * 64 + m * 16 + fr;
#pragma unroll
            for (int bj = 0; bj < 2; ++bj) { const int lc = bj * HALF + wc * 32 + 8 * fq; f(row, lc, acc[ai][bj][m][0], acc[ai][bj][m][1]); } }
}
#define EPI_BEGIN epi_loop(acc, u, wr, wc, fr, fq, [&](int row, int lc, f32x4 v0, f32x4 v1) __attribute__((always_inline)) {
#define EPI_END });

__device__ __forceinline__ u32x4 pack8(f32x4 v0, f32x4 v1) { u32x4 w; w.x = cvt_pk_bf16(v0[0], v0[1]); w.y = cvt_pk_bf16(v0[2], v0[3]); w.z = cvt_pk_bf16(v1[0], v1[1]); w.w = cvt_pk_bf16(v1[2], v1[3]); return w; }

struct EpiP1 {
    static constexpr bool PERM = true;
    unsigned char* ws;
    __device__ __forceinline__ void operator()(const f32x4 (&acc)[2][2][4][2], const Unit& u, int wr, int wc, int fr, int fq) const {
        const int pn = u.pn; bf16_t* dst; int ldc, c0; int mode = 0;
        if (pn < 2) { dst = (bf16_t*)(ws + WS_CQ); ldc = 512; c0 = pn * 256; }
        else if (pn == 2) { dst = (bf16_t*)(ws + WS_CKV); ldc = 256; c0 = 0; }
        else if (pn == 3) { dst = (bf16_t*)(ws + WS_KPE); ldc = 64; c0 = 0; mode = 2; }
        else if (pn < 8) { dst = (bf16_t*)(ws + WS_QG); ldc = 1024; c0 = (pn - 4) * 256; }
        else if (pn == 8) { dst = (bf16_t*)(ws + WS_KG); ldc = 256; c0 = 0; }
        else if (pn == 9) { dst = (bf16_t*)(ws + WS_VG); ldc = 256; c0 = 0; }
        else if (pn < 14) { dst = (bf16_t*)(ws + WS_QM); ldc = 1024; c0 = (pn - 10) * 256; }
        else { dst = (bf16_t*)(ws + WS_Z); ldc = 3072; c0 = (pn - 14) * 256; mode = 1; }
        EPI_BEGIN
            if (mode == 1) {
#pragma unroll
                for (int e = 0; e < 4; ++e) { v0[e] = fast_silu(v0[e]); v1[e] = fast_silu(v1[e]); } }
            if (mode != 2 || lc < 64) *(u32x4*)(dst + (size_t)row * ldc + c0 + lc) = pack8(v0, v1);
        EPI_END
    }
};
struct EpiSplit {
    static constexpr bool PERM = true;
    bf16_t* d0; bf16_t* d1; int ldc;
    __device__ __forceinline__ void operator()(const f32x4 (&acc)[2][2][4][2], const Unit& u, int wr, int wc, int fr, int fq) const {
        bf16_t* dst = u.pn < 4 ? d0 : d1; const int c0 = (u.pn & 3) * 256;
        EPI_BEGIN *(u32x4*)(dst + (size_t)row * ldc + c0 + lc) = pack8(v0, v1); EPI_END
    }
};
struct EpiQ {
    static constexpr bool PERM = true;
    bf16_t* dst; const f32x2* tabm;
    __device__ __forceinline__ void operator()(const f32x4 (&acc)[2][2][4][2], const Unit& u, int wr, int wc, int fr, int fq) const {
        EPI_BEGIN
            const int c = u.pn * 256 + lc; const int d = c % 192;
            if (d >= 128) { const int p0 = d - 128, a = p0 >> 5, i0 = (p0 & 31) >> 1; const int s = row & 4095; const int pos = a ? (s & 63) : (s >> 6);
                const f32x4 cs0 = *(const f32x4*)(tabm + pos * 16 + i0), cs1 = *(const f32x4*)(tabm + pos * 16 + i0 + 2);
                f32x4 r0, r1;
                r0[0] = v0[0] * cs0[0] - v0[1] * cs0[1]; r0[1] = v0[1] * cs0[0] + v0[0] * cs0[1];
                r0[2] = v0[2] * cs0[2] - v0[3] * cs0[3]; r0[3] = v0[3] * cs0[2] + v0[2] * cs0[3];
                r1[0] = v1[0] * cs1[0] - v1[1] * cs1[1]; r1[1] = v1[1] * cs1[0] + v1[0] * cs1[1];
                r1[2] = v1[2] * cs1[2] - v1[3] * cs1[3]; r1[3] = v1[3] * cs1[2] + v1[2] * cs1[3];
                v0 = r0; v1 = r1; }
            *(u32x4*)(dst + (size_t)row * 1536 + c) = pack8(v0, v1);
        EPI_END
    }
};
struct EpiGL {
    static constexpr bool PERM = true;
    bf16_t* dst; float scale;
    __device__ __forceinline__ void operator()(const f32x4 (&acc)[2][2][4][2], const Unit& u, int wr, int wc, int fr, int fq) const {
        EPI_BEGIN
#pragma unroll
            for (int e = 0; e < 4; ++e) { v0[e] = fast_sigmoid(v0[e] * scale); v1[e] = fast_sigmoid(v1[e] * scale); }
            u32x4 w_; w_.x = cvt_pk_bf16_safe(v0[0], v0[1]); w_.y = cvt_pk_bf16_safe(v0[2], v0[3]); w_.z = cvt_pk_bf16_safe(v1[0], v1[1]); w_.w = cvt_pk_bf16_safe(v1[2], v1[3]);
            *(u32x4*)(dst + (size_t)row * 6144 + u.pn * 256 + lc) = w_;
        EPI_END
    }
};
struct EpiBR {
    static constexpr bool PERM = true;
    const bf16_t* gl; bf16_t* merged; int first;
    __device__ __forceinline__ void operator()(const f32x4 (&acc)[2][2][4][2], const Unit& u, int wr, int wc, int fr, int fq) const {
        EPI_BEGIN
            const int c = u.pn * 256 + lc;
            const u32x4 gw = *(const u32x4*)(gl + (size_t)row * 6144 + c);
            bf16_t* mp = merged + (size_t)row * 2048 + c;
            f32x4 p0 = (f32x4){0.f, 0.f, 0.f, 0.f}, p1 = p0;
            if (!first) { const u32x4 pw = *(const u32x4*)mp; p0 = (f32x4){bf_lo(pw.x), bf_hi(pw.x), bf_lo(pw.y), bf_hi(pw.y)}; p1 = (f32x4){bf_lo(pw.z), bf_hi(pw.z), bf_lo(pw.w), bf_hi(pw.w)}; }
            v0[0] = p0[0] + v0[0] * bf_lo(gw.x); v0[1] = p0[1] + v0[1] * bf_hi(gw.x); v0[2] = p0[2] + v0[2] * bf_lo(gw.y); v0[3] = p0[3] + v0[3] * bf_hi(gw.y);
            v1[0] = p1[0] + v1[0] * bf_lo(gw.z); v1[1] = p1[1] + v1[1] * bf_hi(gw.z); v1[2] = p1[2] + v1[2] * bf_lo(gw.w); v1[3] = p1[3] + v1[3] * bf_hi(gw.w);
            *(u32x4*)mp = pack8(v0, v1);
        EPI_END
    }
};
struct EpiOut {
    static constexpr bool PERM = true;
    const float* xp; const float* xs; float* out; float* ssq;
    __device__ __forceinline__ void operator()(const f32x4 (&acc)[2][2][4][2], const Unit& u, int wr, int wc, int fr, int fq) const {
#pragma unroll
        for (int ai = 0; ai < 2; ++ai)
#pragma unroll
            for (int m = 0; m < 4; ++m) { const int row = u.pm * BM + ai * HALF + wr * 64 + m * 16 + fr;
                const float* xr = row < TP ? xp + (size_t)row * DM : xs + (size_t)(row - TP) * DM; float* orow = out + (size_t)row * DM; float sq = 0.f;
#pragma unroll
                for (int bj = 0; bj < 2; ++bj) { const int c = u.pn * 256 + bj * HALF + wc * 32 + 8 * fq;
                    f32x4 v0 = acc[ai][bj][m][0] * PROBE_BETA + *(const f32x4*)(xr + c), v1 = acc[ai][bj][m][1] * PROBE_BETA + *(const f32x4*)(xr + c + 4);
                    sq += (v0[0] * v0[0] + v0[1] * v0[1]) + (v0[2] * v0[2] + v0[3] * v0[3]) + (v1[0] * v1[0] + v1[1] * v1[1]) + (v1[2] * v1[2] + v1[3] * v1[3]);
                    *(f32x4*)(orow + c) = v0; *(f32x4*)(orow + c + 4) = v1; }
                sq += __shfl_xor(sq, 16); sq += __shfl_xor(sq, 32);
                if (fq == 0) ssq[(size_t)row * 32 + u.pn * 4 + wc] = sq; }
    }
};
}

#ifndef ATT_SDX
#define ATT_SDX 1
#endif
#ifndef QKT_SBAR
#define QKT_SBAR SBAR()
#endif
namespace att {
constexpr int QBLK = 32, KVBLK = 64, NW = 8;
constexpr float THR = 8.f;
constexpr int SHM_V = KVBLK * 128 * 2, SHM_K = KVBLK * 128 * 2, SHM_KX = KVBLK * 144;
constexpr int OFF_V = 0, OFF_K = 2 * SHM_V, OFF_KX = OFF_K + 2 * SHM_K, OFF_WS = OFF_KX + 2 * SHM_KX, OFF_QX = OFF_WS + NW * 64 * 4, SHM_ATTN = OFF_QX + NW * 4 * 64 * 16;
static_assert(SHM_ATTN <= 131072, "attention LDS");
#define KSWZ(row, colB) ((row) * 256 + ((colB) ^ (((row) & 7) << 4)))
#define KXSWZ(row, cbi) ((row) * 144 + ((cbi) << 4))
#define SBAR() __builtin_amdgcn_sched_barrier(0)
__device__ __forceinline__ int crow(int r, int hi) { return (r & 3) + 8 * (r >> 2) + 4 * hi; }

template <int SC> __device__ __forceinline__ void partialSM(f32x16& p0, f32x16& p1, float& m_reg, float& mn, float& alpha) {
  constexpr float SCALE = SC == 192 ? 0.07216878364870323f : 0.08838834764831843f;
  constexpr float C = SCALE * 1.4426950408889634f;
  float pmax = p0[0];
#pragma unroll
  for (int r = 1; r < 16; ++r) pmax = fmaxf(pmax, p0[r]);
#pragma unroll
  for (int r = 0; r < 16; ++r) pmax = fmaxf(pmax, p1[r]);
  { auto rr = __builtin_amdgcn_permlane32_swap(__float_as_uint(pmax), __float_as_uint(pmax), false, false);
    pmax = fmaxf(__uint_as_float(rr[0]), __uint_as_float(rr[1])); }
  if (__builtin_expect(__all(pmax - m_reg <= THR / SCALE), 1)) { mn = m_reg; alpha = 1.f; }
  else { mn = fmaxf(m_reg, pmax); alpha = __builtin_amdgcn_exp2f((m_reg - mn) * C); m_reg = mn; }
  float mnC = -mn * C;
#pragma unroll
  for (int r = 0; r < 16; ++r) p0[r] = fmaf(p0[r], C, mnC);
#pragma unroll
  for (int r = 0; r < 16; ++r) p1[r] = fmaf(p1[r], C, mnC);
#pragma unroll
  for (int r = 0; r < 16; ++r) p0[r] = __builtin_amdgcn_exp2f(p0[r]);
}
__device__ __forceinline__ void finishSM(f32x16& p0, f32x16& p1, float alpha, float& l_reg, bf16x8& pa0, bf16x8& pa1, bf16x8& pa2, bf16x8& pa3) {
#pragma unroll
  for (int r = 0; r < 16; ++r) p1[r] = __builtin_amdgcn_exp2f(p1[r]);
  float ps = 0;
#pragma unroll
  for (int r = 0; r < 16; ++r) ps += p0[r];
#pragma unroll
  for (int r = 0; r < 16; ++r) ps += p1[r];
  { auto rr = __builtin_amdgcn_permlane32_swap(__float_as_uint(ps), __float_as_uint(ps), false, false);
    ps = __uint_as_float(rr[0]) + __uint_as_float(rr[1]); }
  l_reg = l_reg * alpha + ps;
  SBAR();
#define PK4(P, BASE, OUT) do { unsigned a0 = cvt_pk_bf16(P[BASE + 0], P[BASE + 1]), a1 = cvt_pk_bf16(P[BASE + 2], P[BASE + 3]);   \
    unsigned b0 = cvt_pk_bf16(P[BASE + 4], P[BASE + 5]), b1 = cvt_pk_bf16(P[BASE + 6], P[BASE + 7]);                              \
    auto r0 = __builtin_amdgcn_permlane32_swap(a0, b0, false, false); auto r1 = __builtin_amdgcn_permlane32_swap(a1, b1, false, false); \
    u32x4 w = {r0[0], r1[0], r0[1], r1[1]}; OUT = *reinterpret_cast<bf16x8*>(&w); } while (0)
  PK4(p0, 0, pa0); PK4(p0, 8, pa1); PK4(p1, 0, pa2); PK4(p1, 8, pa3);
#undef PK4
}
template <int DKX> __device__ __forceinline__ void qkt(f32x16& p0, f32x16& p1, const LAS char* Ks, const LAS char* Kxs, const bf16x8* qr, const LAS char* qx, int r32, int hi) {
  p0 = f32x16{}; p1 = f32x16{};
#pragma unroll
  for (int d0 = 0; d0 < 8; ++d0) { int cb = (d0 * 16 + hi * 8) * 2;
    bf16x8 b0 = *(const LAS bf16x8*)(Ks + KSWZ(r32, cb));
    bf16x8 b1 = *(const LAS bf16x8*)(Ks + KSWZ(32 + r32, cb));
    p0 = __builtin_amdgcn_mfma_f32_32x32x16_bf16(b0, qr[d0], p0, 0, 0, 0);
    p1 = __builtin_amdgcn_mfma_f32_32x32x16_bf16(b1, qr[d0], p1, 0, 0, 0); }
  if constexpr (DKX > 0) {
    int zz = 0; asm volatile("" : "+v"(zz)); qx += zz;
    const LAS char* kxp = Kxs + KXSWZ(r32, hi);
#pragma unroll
    for (int dx = 0; dx < DKX / 16; ++dx) {
      bf16x8 b0 = *(const LAS bf16x8*)(kxp + dx * 32);
      bf16x8 b1 = *(const LAS bf16x8*)(kxp + dx * 32 + 32 * 144);
      const bf16x8 qf = *(const LAS bf16x8*)(qx + dx * 1024);
      p0 = __builtin_amdgcn_mfma_f32_32x32x16_bf16(b0, qf, p0, 0, 0, 0);
      p1 = __builtin_amdgcn_mfma_f32_32x32x16_bf16(b1, qf, p1, 0, 0, 0); }
  }
}
__device__ __forceinline__ int v_st(int k, int c) { const int kk = (k & ~0xC) | ((k & 4) << 1) | ((k & 8) >> 1); return ((kk >> 3) * 4 + (c >> 5)) * 512 + ((kk & 7) * 32 + (c & 31)) * 2; }
__device__ __forceinline__ int v_rd_base(int lane) { return ((lane & 3) << 3) | (((lane >> 2) & 3) << 6) | (((lane >> 4) & 1) << 5) | (((lane >> 5) & 1) << 8); }
constexpr int v_rd_off(int d0, int ks, int half) { return d0 * 512 + ks * 4096 + half * 2048; }
template <int OFF> __device__ __forceinline__ s16x4 tr_read(int vb) {
  s16x4 r; asm volatile("ds_read_b64_tr_b16 %0, %1 offset:%2" : "=&v"(r) : "v"(vb), "i"(OFF) : "memory"); return r;
}
template <int D0> __device__ __forceinline__ void pv_one(f32x16& od, int vb, bf16x8 pa0, bf16x8 pa1, bf16x8 pa2, bf16x8 pa3) {
  const s16x4 l0 = tr_read<v_rd_off(D0, 0, 0)>(vb), h0 = tr_read<v_rd_off(D0, 0, 1)>(vb), l1 = tr_read<v_rd_off(D0, 1, 0)>(vb), h1 = tr_read<v_rd_off(D0, 1, 1)>(vb);
  const s16x4 l2 = tr_read<v_rd_off(D0, 2, 0)>(vb), h2 = tr_read<v_rd_off(D0, 2, 1)>(vb), l3 = tr_read<v_rd_off(D0, 3, 0)>(vb), h3 = tr_read<v_rd_off(D0, 3, 1)>(vb);
  asm volatile("s_waitcnt lgkmcnt(0)" ::: "memory"); SBAR();
#define PK(L, H) (bf16x8){L[0], L[1], L[2], L[3], H[0], H[1], H[2], H[3]}
  od = __builtin_amdgcn_mfma_f32_32x32x16_bf16(pa0, PK(l0, h0), od, 0, 0, 0);
  od = __builtin_amdgcn_mfma_f32_32x32x16_bf16(pa1, PK(l1, h1), od, 0, 0, 0);
  od = __builtin_amdgcn_mfma_f32_32x32x16_bf16(pa2, PK(l2, h2), od, 0, 0, 0);
  od = __builtin_amdgcn_mfma_f32_32x32x16_bf16(pa3, PK(l3, h3), od, 0, 0, 0);
#undef PK
}
__device__ __forceinline__ void pv_d0(f32x16* o, int vb, bf16x8 pa0, bf16x8 pa1, bf16x8 pa2, bf16x8 pa3) {
  pv_one<0>(o[0], vb, pa0, pa1, pa2, pa3); pv_one<1>(o[1], vb, pa0, pa1, pa2, pa3); pv_one<2>(o[2], vb, pa0, pa1, pa2, pa3); pv_one<3>(o[3], vb, pa0, pa1, pa2, pa3);
}

template <int DKX, int LDQ, int LDK, int LDV, int SC>
__device__ __forceinline__ void attn_unit(const bf16_t* __restrict__ Qb, const bf16_t* __restrict__ Kh, const bf16_t* __restrict__ Kx, const bf16_t* __restrict__ Vh,
                                          bf16_t* Zb, int seq, LAS char* lds) {
  constexpr int SDEPTH = (DKX > 0) ? ATT_SDX : 2; constexpr int NQ = 8; constexpr int LDO = 3072;
  int tid = threadIdx.x; asm volatile("" : "+v"(tid));
  const int wid = tid >> 6, lane = tid & 63, r32 = lane & 31, hi = lane >> 5;
  LAS char* V_lds = lds + OFF_V; LAS char* K_lds = lds + OFF_K; LAS char* KX_lds = lds + OFF_KX;
  LAS float* ws = (LAS float*)(lds + OFF_WS) + wid * 64; LAS float* li_l = ws; LAS float* al_l = ws + 32;
  float m_reg = -1e30f, l_reg = 0; f32x16 o[4] = {}; bf16x8 qr[NQ];
  const bf16_t* Qw = Qb + (long)(wid * QBLK + r32) * LDQ + hi * 8;
#pragma unroll
  for (int d0 = 0; d0 < NQ; ++d0) qr[d0] = *reinterpret_cast<const bf16x8*>(Qw + d0 * 16);
  LAS char* qx = lds + OFF_QX + (wid * 256 + lane) * 16;
  if constexpr (DKX > 0) {
#pragma unroll
    for (int dx = 0; dx < DKX / 16; ++dx) *(LAS bf16x8*)(qx + dx * 1024) = *reinterpret_cast<const bf16x8*>(Qw + 128 + dx * 16);
  }
  const int sr = tid >> 4, sc = (tid & 15) * 8, vst0 = v_st(sr, sc), vst1 = v_st(32 + sr, sc);
  const int xr = tid >> 3, xc = tid & 7, kxst = KXSWZ(xr, xc);
  const int vb0 = (int)(unsigned)(uintptr_t)V_lds + v_rd_base(lane);
  const unsigned vof0 = (unsigned)(sr * LDV + sc), vof1 = vof0 + 32u * LDV, kof0 = (unsigned)(sr * LDK + sc), kof1 = kof0 + 32u * LDK, xof = (unsigned)(xr * 64 + xc * 8);
  struct { bf16x8 vs0, vs1, ks0, ks1, kx; } sr_[SDEPTH];
#define SLOAD(i, k0) do { const bf16_t* Vt_ = Vh + (size_t)(k0) * LDV; const bf16_t* Kt_ = Kh + (size_t)(k0) * LDK; \
    sr_[i].vs0 = *reinterpret_cast<const bf16x8*>(Vt_ + vof0); sr_[i].vs1 = *reinterpret_cast<const bf16x8*>(Vt_ + vof1); \
    sr_[i].ks0 = *reinterpret_cast<const bf16x8*>(Kt_ + kof0); sr_[i].ks1 = *reinterpret_cast<const bf16x8*>(Kt_ + kof1); \
    if constexpr (DKX > 0) { const bf16_t* Xt_ = Kx + (size_t)(k0) * 64; sr_[i].kx = *reinterpret_cast<const bf16x8*>(Xt_ + xof); } } while (0)
#define SWRITE(b, i) do { *(LAS bf16x8*)(V_lds + (b) * SHM_V + vst0) = sr_[i].vs0;          \
    *(LAS bf16x8*)(V_lds + (b) * SHM_V + vst1) = sr_[i].vs1; int kc = sc * 2;               \
    *(LAS bf16x8*)(K_lds + (b) * SHM_K + KSWZ(sr, kc)) = sr_[i].ks0;                       \
    *(LAS bf16x8*)(K_lds + (b) * SHM_K + KSWZ(32 + sr, kc)) = sr_[i].ks1;                   \
    if constexpr (DKX > 0) *(LAS bf16x8*)(KX_lds + (b) * SHM_KX + kxst) = sr_[i].kx; } while (0)
#define SWAIT() do { if constexpr (SDEPTH == 1) asm volatile("s_waitcnt vmcnt(0)" ::: "memory"); else if constexpr (DKX > 0) asm volatile("s_waitcnt vmcnt(5)" ::: "memory"); else asm volatile("s_waitcnt vmcnt(4)" ::: "memory"); } while (0)
#define RESC(a) do { if (__any((a) < 1.f)) { if (hi == 0) al_l[r32] = (a); asm volatile("s_waitcnt lgkmcnt(0)" ::: "memory"); \
    _Pragma("unroll") for (int d = 0; d < 4; ++d) _Pragma("unroll") for (int r = 0; r < 16; ++r) o[d][r] *= al_l[crow(r, hi)]; } } while (0)
  f32x16 pA0, pA1, pB0, pB1; float mnA, mnB, alA, alB; bf16x8 pa0, pa1, pa2, pa3; const int NT = seq / KVBLK;
  constexpr int SE = 0, SO = SDEPTH - 1;
  SLOAD(SE, 0); asm volatile("s_waitcnt vmcnt(0)" ::: "memory"); SWRITE(0, SE); __syncthreads();
  qkt<DKX>(pA0, pA1, K_lds, KX_lds, qr, qx, r32, hi); partialSM<SC>(pA0, pA1, m_reg, mnA, alA);
  SLOAD(SO, KVBLK); if constexpr (SDEPTH == 2) { if (2 < NT) SLOAD(SE, 2 * KVBLK); }
  SWAIT(); SWRITE(1, SO); __syncthreads();
  for (int j = 1; j + 1 < NT; j += 2) {
    SBAR(); qkt<DKX>(pB0, pB1, K_lds + SHM_K, KX_lds + SHM_KX, qr, qx, r32, hi);
    finishSM(pA0, pA1, alA, l_reg, pa0, pa1, pa2, pa3); SBAR();
    SLOAD(SO, (j + SDEPTH) * KVBLK); SBAR();
    pv_d0(o, vb0, pa0, pa1, pa2, pa3); partialSM<SC>(pB0, pB1, m_reg, mnB, alB);
    __syncthreads(); SWAIT(); SWRITE(0, SE);
    RESC(alB); __syncthreads();
    SBAR(); qkt<DKX>(pA0, pA1, K_lds, KX_lds, qr, qx, r32, hi);
    finishSM(pB0, pB1, alB, l_reg, pa0, pa1, pa2, pa3); SBAR();
    if (SDEPTH == 1 || j + 3 < NT) SLOAD(SE, (j + 1 + SDEPTH) * KVBLK); SBAR();
    pv_d0(o, vb0 + (int)SHM_V, pa0, pa1, pa2, pa3); partialSM<SC>(pA0, pA1, m_reg, mnA, alA);
    __syncthreads(); SWAIT(); SWRITE(1, SO);
    RESC(alA); __syncthreads();
  }
  SBAR(); qkt<DKX>(pB0, pB1, K_lds + SHM_K, KX_lds + SHM_KX, qr, qx, r32, hi);
  finishSM(pA0, pA1, alA, l_reg, pa0, pa1, pa2, pa3); SBAR();
  pv_d0(o, vb0, pa0, pa1, pa2, pa3); partialSM<SC>(pB0, pB1, m_reg, mnB, alB);
  __syncthreads(); RESC(alB);
  finishSM(pB0, pB1, alB, l_reg, pa0, pa1, pa2, pa3); SBAR();
  pv_d0(o, vb0 + (int)SHM_V, pa0, pa1, pa2, pa3);
  if (hi == 0) li_l[r32] = l_reg; asm volatile("s_waitcnt lgkmcnt(0)" ::: "memory");
#pragma unroll
  for (int r = 0; r < 16; ++r) { const float rl_ = __builtin_amdgcn_rcpf(li_l[crow(r, hi)]);
#pragma unroll
    for (int d0 = 0; d0 < 4; ++d0) o[d0][r] *= rl_; }
  bf16_t* Zw = Zb + (long)(wid * QBLK) * LDO + r32;
#pragma unroll
  for (int d0 = 0; d0 < 4; ++d0)
#pragma unroll
    for (int rh = 0; rh < 2; ++rh) { bf16_t zv[8];
#pragma unroll
      for (int r = 0; r < 8; ++r) zv[r] = Zw[(long)crow(rh * 8 + r, hi) * LDO + d0 * 32];
#pragma unroll
      for (int r = 0; r < 8; ++r) Zw[(long)crow(rh * 8 + r, hi) * LDO + d0 * 32] = (bf16_t)(cvt_pk_bf16(o[d0][rh * 8 + r] * __uint_as_float((unsigned)zv[r] << 16), 0.f) & 0xffffu); }
#undef SLOAD
#undef SWRITE
#undef SWAIT
#undef RESC
}
}

__device__ __forceinline__ void mem_attn_wave(const bf16_t* __restrict__ QM, const bf16_t* __restrict__ KM, const bf16_t* __restrict__ VMT, bf16_t* Z, int b, int h, int rg, int lane) {
    const int jr = lane & 15, q = lane >> 4;
    const size_t row = (size_t)b * SEQ + rg * 16 + jr;
    bf16x8 qf[8];
#pragma unroll
    for (int c = 0; c < 8; ++c) qf[c] = *(const bf16x8*)(QM + row * 1024 + h * 256 + 32 * c + 8 * q);
    f32x4 S[16];
    const bf16_t* kb = KM + ((size_t)b * 256 + jr) * 1024 + h * 256 + 8 * q;
#pragma unroll
    for (int n = 0; n < 16; ++n) { f32x4 acc = (f32x4){0.f, 0.f, 0.f, 0.f};
#pragma unroll
        for (int c = 0; c < 8; ++c) { const bf16x8 kf = *(const bf16x8*)(kb + (size_t)n * 16 * 1024 + 32 * c); acc = __builtin_amdgcn_mfma_f32_16x16x32_bf16(kf, qf[c], acc, 0, 0, 0); }
        S[n] = acc; }
    float m = -1e30f;
#pragma unroll
    for (int n = 0; n < 16; ++n) m = fmaxf(fmaxf(fmaxf(S[n][0], S[n][1]), fmaxf(S[n][2], S[n][3])), m);
    m = fmaxf(m, __shfl_xor(m, 16)); m = fmaxf(m, __shfl_xor(m, 32));
    constexpr float C = 0.0625f * 1.4426950408889634f; const float mC = -m * C; float l = 0.f;
#pragma unroll
    for (int n = 0; n < 16; ++n)
#pragma unroll
        for (int e = 0; e < 4; ++e) { const float p = __builtin_amdgcn_exp2f(fmaf(S[n][e], C, mC)); S[n][e] = p; l += p; }
    l += __shfl_xor(l, 16); l += __shfl_xor(l, 32);
    const float rl = __builtin_amdgcn_rcpf(l);
    __builtin_amdgcn_sched_barrier(0);
    bf16x8 pf[8];
#pragma unroll
    for (int c = 0; c < 8; ++c) { u32x4 w; w.x = cvt_pk_bf16(S[2 * c][0], S[2 * c][1]); w.y = cvt_pk_bf16(S[2 * c][2], S[2 * c][3]); w.z = cvt_pk_bf16(S[2 * c + 1][0], S[2 * c + 1][1]); w.w = cvt_pk_bf16(S[2 * c + 1][2], S[2 * c + 1][3]);
        pf[c] = *reinterpret_cast<bf16x8*>(&w); }
    const bf16_t* vb = VMT + ((size_t)h * 256 + jr) * MEMROWS + b * 256 + 8 * q;
    bf16_t* zrow = Z + row * 3072 + 2048 + h * 256 + 4 * q;
    u32x2 zz[16];
#pragma unroll
    for (int n = 0; n < 16; ++n) zz[n] = *(const u32x2*)(zrow + 16 * n);
#pragma unroll
    for (int n = 0; n < 16; ++n) { f32x4 acc = (f32x4){0.f, 0.f, 0.f, 0.f};
#pragma unroll
        for (int c = 0; c < 8; ++c) { const bf16x8 vf = *(const bf16x8*)(vb + (size_t)n * 16 * MEMROWS + 32 * c); acc = __builtin_amdgcn_mfma_f32_16x16x32_bf16(vf, pf[c], acc, 0, 0, 0); }
        u32x2 w; w.x = cvt_pk_bf16(acc[0] * rl * bf_lo(zz[n].x), acc[1] * rl * bf_hi(zz[n].x)); w.y = cvt_pk_bf16(acc[2] * rl * bf_lo(zz[n].y), acc[3] * rl * bf_hi(zz[n].y));
        *(u32x2*)(zrow + 16 * n) = w; }
}


__device__ __forceinline__ void mem_attn_block(const bf16_t* __restrict__ QM, const bf16_t* __restrict__ KM, const bf16_t* __restrict__ VMT, bf16_t* Z, int b, int h, int rb, LAS unsigned char* lds, int tid_in) {
    int tid = tid_in; asm volatile("" : "+v"(tid));
    const int wave = tid >> 6, lane = tid & 63, jr = lane & 15, q = lane >> 4;
    const size_t row = (size_t)b * SEQ + rb * 128 + wave * 16 + jr;
    {
        u32x4 st[16];
#pragma unroll
        for (int i = 0; i < 16; ++i) { const int g = tid + 512 * i, r_ = g >> 5, ch = g & 31; st[i] = *(const u32x4*)(KM + ((size_t)b * 256 + r_) * 1024 + h * 256 + ch * 8); }
#pragma unroll
        for (int i = 0; i < 16; ++i) { const int g = tid + 512 * i, r_ = g >> 5, ch = g & 31; *(LAS u32x4*)(lds + r_ * 512 + ((ch ^ (r_ & 15)) << 4)) = st[i]; }
    }
    bf16x8 qf[8];
#pragma unroll
    for (int c = 0; c < 8; ++c) qf[c] = *(const bf16x8*)(QM + row * 1024 + h * 256 + 32 * c + 8 * q);
    __syncthreads();
    f32x4 S[16];
#pragma unroll
    for (int n = 0; n < 16; ++n) { f32x4 acc = (f32x4){0.f, 0.f, 0.f, 0.f};
#pragma unroll
        for (int c = 0; c < 8; ++c) { const bf16x8 kf = *(const LAS bf16x8*)(lds + (16 * n + jr) * 512 + (((4 * c + q) ^ jr) << 4)); acc = __builtin_amdgcn_mfma_f32_16x16x32_bf16(kf, qf[c], acc, 0, 0, 0); }
        S[n] = acc; __builtin_amdgcn_sched_barrier(0); }
    float m = -1e30f;
#pragma unroll
    for (int n = 0; n < 16; ++n) m = fmaxf(fmaxf(fmaxf(S[n][0], S[n][1]), fmaxf(S[n][2], S[n][3])), m);
    m = fmaxf(m, __shfl_xor(m, 16)); m = fmaxf(m, __shfl_xor(m, 32));
    constexpr float C = 0.0625f * 1.4426950408889634f; const float mC = -m * C; float l = 0.f;
#pragma unroll
    for (int n = 0; n < 16; ++n)
#pragma unroll
        for (int e = 0; e < 4; ++e) { const float p = __builtin_amdgcn_exp2f(fmaf(S[n][e], C, mC)); S[n][e] = p; l += p; }
    l += __shfl_xor(l, 16); l += __shfl_xor(l, 32);
    const float rl = __builtin_amdgcn_rcpf(l);
    __builtin_amdgcn_sched_barrier(0);
    bf16x8 pf[8];
#pragma unroll
    for (int c = 0; c < 8; ++c) { u32x4 w; w.x = cvt_pk_bf16(S[2 * c][0], S[2 * c][1]); w.y = cvt_pk_bf16(S[2 * c][2], S[2 * c][3]); w.z = cvt_pk_bf16(S[2 * c + 1][0], S[2 * c + 1][1]); w.w = cvt_pk_bf16(S[2 * c + 1][2], S[2 * c + 1][3]);
        pf[c] = *reinterpret_cast<bf16x8*>(&w); }
    bf16_t* zrow = Z + row * 3072 + 2048 + h * 256 + 4 * q;
    u32x2 zz[16];
#pragma unroll
    for (int n = 0; n < 16; ++n) zz[n] = *(const u32x2*)(zrow + 16 * n);
    __syncthreads();
    {
        u32x4 st[16];
#pragma unroll
        for (int i = 0; i < 16; ++i) { const int g = tid + 512 * i, r_ = g >> 5, ch = g & 31; st[i] = *(const u32x4*)(VMT + ((size_t)h * 256 + r_) * MEMROWS + b * 256 + ch * 8); }
#pragma unroll
        for (int i = 0; i < 16; ++i) { const int g = tid + 512 * i, r_ = g >> 5, ch = g & 31; *(LAS u32x4*)(lds + r_ * 512 + ((ch ^ (r_ & 15)) << 4)) = st[i]; }
    }
    __syncthreads();
#pragma unroll
    for (int n = 0; n < 16; ++n) { f32x4 acc = (f32x4){0.f, 0.f, 0.f, 0.f};
#pragma unroll
        for (int c = 0; c < 8; ++c) { const bf16x8 vf = *(const LAS bf16x8*)(lds + (16 * n + jr) * 512 + (((4 * c + q) ^ jr) << 4)); acc = __builtin_amdgcn_mfma_f32_16x16x32_bf16(vf, pf[c], acc, 0, 0, 0); }
        u32x2 w; w.x = cvt_pk_bf16(acc[0] * rl * bf_lo(zz[n].x), acc[1] * rl * bf_hi(zz[n].x)); w.y = cvt_pk_bf16(acc[2] * rl * bf_lo(zz[n].y), acc[3] * rl * bf_hi(zz[n].y));
        *(u32x2*)(zrow + 16 * n) = w; __builtin_amdgcn_sched_barrier(0); }
    __syncthreads();
}

__device__ __forceinline__ int gperm_inv128(int p) { const int a = p >> 6, t = p & 63; return 64 * a + 32 * (t & 1) + (t >> 1); }
__device__ __forceinline__ int gperm_inv64(int p) { const int a = p >> 5, t = p & 31; return 32 * a + 16 * (t & 1) + (t >> 1); }
__device__ __forceinline__ int colmap(int kind, int n) {
    if (kind == 0) {
        if (n < 768) return n;
        if (n < 1024) { const int j = n - 768; return j < 64 ? 768 + gperm_inv64(j) : -1; }
        if (n < 2048) { const int j = n - 1024; return 832 + (j & ~127) + gperm_inv128(j & 127); }
        if (n < 2304) { const int j = n - 2048; return 1856 + (j & ~127) + gperm_inv128(j & 127); }
        return n - 2304 + 2112;
    }
    if (kind == 1) return 6464 + n;
    if (kind == 2) { const int h = n / 192, d = n % 192; return h * 192 + (d < 128 ? d : 128 + gperm_inv64(d - 128)); }
    if (kind == 3) { if (n < 1024) return (n >> 7) * 256 + (n & 127); const int m = n - 1024; return (m >> 7) * 256 + 128 + (m & 127); }
    return n;
}
__device__ __forceinline__ void transpose_item(const float* __restrict__ W, int ldw, int K, bf16_t* WT, int kind, int item, LAS unsigned char* scr, int tid) {
    const int nkb = K >> 6; const int nb = item / nkb, kb = item - nb * nkb; const int n0 = nb * 64, k0 = kb * 64;
    const int nl = tid & 63, kg = tid >> 6;
    const int col = colmap(kind, n0 + nl);
    float v[8];
#pragma unroll
    for (int j = 0; j < 8; ++j) v[j] = col >= 0 ? W[(size_t)(k0 + 8 * kg + j) * ldw + col] : 0.f;
    u32x4 o; o.x = cvt_pk_bf16(v[0], v[1]); o.y = cvt_pk_bf16(v[2], v[3]); o.z = cvt_pk_bf16(v[4], v[5]); o.w = cvt_pk_bf16(v[6], v[7]);
    *(LAS u32x4*)(scr + nl * 144 + kg * 16) = o;
    __syncthreads();
    const int row = tid >> 3, ch = tid & 7;
    const u32x4 w = *(const LAS u32x4*)(scr + row * 144 + ch * 16);
    *(u32x4*)(WT + (size_t)(n0 + row) * K + k0 + 8 * ch) = w;
    __syncthreads();
}

__device__ __forceinline__ unsigned pk4_fp8(float a, float b, float c, float d) { int w = __builtin_amdgcn_cvt_pk_fp8_f32(a, b, 0, false); w = __builtin_amdgcn_cvt_pk_fp8_f32(c, d, w, true); return (unsigned)w; }
__device__ __forceinline__ void transpose_item_fp8(const float* __restrict__ W, int ldw, int K, unsigned char* WT, int col0, int item, LAS unsigned char* scr, int tid) {
    const int nkb = K >> 6; const int nb = item / nkb, kb = item - nb * nkb; const int n0 = nb * 64, k0 = kb * 64;
    const int nl = tid & 63, kg = tid >> 6;
    float v[8];
#pragma unroll
    for (int j = 0; j < 8; ++j) v[j] = W8_SCALE * W[(size_t)(k0 + 8 * kg + j) * ldw + col0 + n0 + nl];
    u32x2 o; o.x = pk4_fp8(v[0], v[1], v[2], v[3]); o.y = pk4_fp8(v[4], v[5], v[6], v[7]);
    *(LAS u32x2*)(scr + nl * 72 + kg * 8) = o;
    __syncthreads();
    const int row = tid >> 3, ch = tid & 7;
    const u32x2 w = *(const LAS u32x2*)(scr + row * 72 + ch * 8);
    *(u32x2*)(WT + (size_t)(n0 + row) * K + k0 + 8 * ch) = w;
    __syncthreads();
}
__device__ __forceinline__ void rms_row_to_bf16(const float* __restrict__ xrow, const float* __restrict__ g, bf16_t* orow, unsigned char* o8row, int lane) {
    f32x4 v[8]; float s = 0.f;
#pragma unroll
    for (int j = 0; j < 8; ++j) { v[j] = ((const f32x4*)xrow)[lane + 64 * j]; s += (v[j][0] * v[j][0] + v[j][1] * v[j][1]) + (v[j][2] * v[j][2] + v[j][3] * v[j][3]); }
    const float rstd = 1.0f / sqrtf(wave_sum(s) * (1.f / DM) + EPS);
#pragma unroll
    for (int j = 0; j < 8; ++j) { const f32x4 gg = ((const f32x4*)g)[lane + 64 * j]; u32x2 w; w.x = cvt_pk_bf16(v[j][0] * rstd * gg[0], v[j][1] * rstd * gg[1]); w.y = cvt_pk_bf16(v[j][2] * rstd * gg[2], v[j][3] * rstd * gg[3]);
        ((u32x2*)orow)[lane + 64 * j] = w;
        if (o8row) ((unsigned*)o8row)[lane + 64 * j] = pk4_fp8(H8_SCALE * v[j][0] * rstd * gg[0], H8_SCALE * v[j][1] * rstd * gg[1], H8_SCALE * v[j][2] * rstd * gg[2], H8_SCALE * v[j][3] * rstd * gg[3]); }
}
__device__ __forceinline__ void sincos_d(float angf, float& c, float& s) {
    const double a = (double)angf; const double kq = rint(a * 0.63661977236758134308); const double r = a - kq * 1.57079632679489661923; const int qd = ((int)kq) & 3;
    const double r2 = r * r;
    const double sp = r * (1.0 + r2 * (-1.0 / 6 + r2 * (1.0 / 120 + r2 * (-1.0 / 5040 + r2 * (1.0 / 362880 + r2 * (-1.0 / 39916800 + r2 * (1.0 / 6227020800.0)))))));
    const double cp = 1.0 + r2 * (-0.5 + r2 * (1.0 / 24 + r2 * (-1.0 / 720 + r2 * (1.0 / 40320 + r2 * (-1.0 / 3628800 + r2 * (1.0 / 479001600 + r2 * (-1.0 / 87178291200.0)))))));
    double sv, cv;
    if (qd == 0) { sv = sp; cv = cp; } else if (qd == 1) { sv = cp; cv = -sp; } else if (qd == 2) { sv = -sp; cv = -cp; } else { sv = -cp; cv = sp; }
    c = (float)cv; s = (float)sv;
}

__device__ __forceinline__ void grid_barrier(unsigned* ctr, unsigned target) {
    __syncthreads();
    if (threadIdx.x == 0) {
        __builtin_amdgcn_fence(__ATOMIC_RELEASE, "agent");
        __hip_atomic_fetch_add(ctr, 1u, __ATOMIC_RELAXED, __HIP_MEMORY_SCOPE_AGENT);
        while (__hip_atomic_load(ctr, __ATOMIC_RELAXED, __HIP_MEMORY_SCOPE_AGENT) < target) __builtin_amdgcn_s_sleep(4);
    }
    __syncthreads();
    __builtin_amdgcn_fence(__ATOMIC_ACQUIRE, "agent");
}
struct Args { const float* in[17]; float* out; unsigned char* ws; int ph_lo, ph_hi; };
constexpr int NPHASE = 9;

template <bool COOP>
__global__ void __launch_bounds__(512) mk_fwd(Args args) {
    extern __shared__ __attribute__((aligned(16))) unsigned char lds_raw[];
    LAS unsigned char* lds = (LAS unsigned char*)lds_raw;
    const int tid = threadIdx.x, lane = tid & 63, wave = __builtin_amdgcn_readfirstlane(tid >> 6);
    const int G = gridDim.x, bid = blockIdx.x;
    const int gw = bid * 8 + wave, NGW = G * 8;
    unsigned char* ws = args.ws; unsigned char* dob = (unsigned char*)args.out;
    const float* xp = args.in[0]; const float* xs = args.in[1];
    bf16_t* H = (bf16_t*)(dob + DO_H); bf16_t* QMLA = (bf16_t*)(dob + DO_QMLA); bf16_t* MN = (bf16_t*)(dob + DO_MN);
    f32x2* TABG = (f32x2*)(ws + WS_TABG); f32x2* TABM = (f32x2*)(ws + WS_TABM); float* GQP = (float*)(ws + WS_GQP); float* GKP = (float*)(ws + WS_GKP);
    const int lo = args.ph_lo, hi = args.ph_hi;
    if constexpr (COOP) cg::this_grid().sync();
    __builtin_amdgcn_fence(__ATOMIC_ACQUIRE, "agent");
#ifndef ONLY
#define ONLY -1
#endif
#define IN(k) ((ONLY < 0 || ONLY == (k)) && lo <= (k) && (k) < hi)
#define SEAM(k) do { if constexpr (COOP) { if (IN(k) && IN((k) + 1)) { grid_barrier((unsigned*)(ws + WS_BAR), (unsigned)((k) + 1) * (unsigned)G); } } } while (0)

    if (IN(0)) {
        constexpr int I0 = (NP1 / 64) * 32, I1 = 96 * 32, I2 = 24 * 8, I3 = 32 * 4, I4 = 32 * 32, I5 = 32 * 16, I6 = 32 * 32;
        constexpr int NITEMS = I0 + I1 + I2 + I3 + I4 + 3 * I5 + I6;
        for (int it = bid; it < NITEMS; it += G) {
            int r = it;
            if (r < I0) { transpose_item(args.in[5], 12608, 2048, (bf16_t*)(ws + WS_WIN), 0, r, lds, tid); continue; } r -= I0;
            if (r < I1) { transpose_item_fp8(args.in[5], 12608, 2048, ws + WS_WGL, 6464, r, lds, tid); continue; } r -= I1;
            if (r < I2) { transpose_item(args.in[7], 1536, 512, (bf16_t*)(ws + WS_WQB), 2, r, lds, tid); continue; } r -= I2;
            if (r < I3) { transpose_item(args.in[9], 2048, 256, (bf16_t*)(ws + WS_WKVB), 3, r, lds, tid); continue; } r -= I3;
            if (r < I4) { transpose_item(args.in[13], 2048, 2048, (bf16_t*)(ws + WS_WMKV), 4, r, lds, tid); continue; } r -= I4;
            if (r < 3 * I5) { const int i = r / I5; transpose_item(args.in[14] + (size_t)i * 1024 * 2048, 2048, 1024, (bf16_t*)(ws + WS_WBR) + (size_t)i * 2048 * 1024, 4, r - i * I5, lds, tid); continue; } r -= 3 * I5;
            transpose_item(args.in[15], 2048, 2048, (bf16_t*)(ws + WS_WOUT), 4, r, lds, tid);
        }
        for (int m = gw; m < T + MEMROWS; m += NGW) {
            if (m < T) { const float* xr = m < TP ? xp + (size_t)m * DM : xs + (size_t)(m - TP) * DM; rms_row_to_bf16(xr, args.in[4], H + (size_t)m * DM, ws + WS_H8 + (size_t)m * DM, lane); }
            else { const int mm = m - T; const float* xr = mm < 2048 ? args.in[2] + (size_t)mm * DM : args.in[3] + (size_t)(mm - 2048) * DM; rms_row_to_bf16(xr, args.in[12], MN + (size_t)mm * DM, nullptr, lane); }
        }
        for (int e = bid * 512 + tid; e < 4096 * 64 * 2 / 16; e += G * 512) ((u32x4*)(ws + WS_ZERO))[e] = (u32x4){0u, 0u, 0u, 0u};
        if (bid == 0) {
            for (int e = tid; e < 64 * 32; e += 512) { const int pos = e >> 5, i = e & 31; double f = 1.0; for (int k = 0; k < i; ++k) f *= 0.7498942093324559; const float ang = (float)pos * (float)f; float c, s; sincos_d(ang, c, s); TABG[e] = (f32x2){c, s}; }
            for (int e = tid; e < 64 * 16; e += 512) { const int pos = e >> 4, i = e & 15; double f = 1.0; for (int k = 0; k < i; ++k) f *= 0.5623413251903491; const float ang = (float)pos * (float)f; float c, s; sincos_d(ang, c, s); TABM[e] = (f32x2){c, s}; }
            if (tid < 128) { GQP[tid] = args.in[10][gperm_inv128(tid)]; GKP[tid] = args.in[11][gperm_inv128(tid)]; }
        }
    }
    SEAM(0);

    if (IN(1)) {
        { pg8::Gemm g{H, (const bf16_t*)(ws + WS_WIN), 2048, 2048, T, NP1, 2048}; pg8::StaticOrder S; S.init(T, NP1, G, bid);
          pg8::EpiP1 E{ws}; pg8::gemm_phase(lds, g, S, E); }
        { pg8::Gemm g{MN, (const bf16_t*)(ws + WS_WMKV), 2048, 2048, MEMROWS, 2048, 2048}; pg8::StaticOrder S; S.init(MEMROWS, 2048, G, (bid + 128) % G);
          pg8::EpiSplit E{(bf16_t*)(ws + WS_KM), (bf16_t*)(ws + WS_VM), 1024}; pg8::gemm_phase(lds, g, S, E); }
    }
    SEAM(1);

    if (IN(2)) {
        bf16_t* CQ = (bf16_t*)(ws + WS_CQ); bf16_t* CKV = (bf16_t*)(ws + WS_CKV); bf16_t* KPE = (bf16_t*)(ws + WS_KPE); bf16_t* QG = (bf16_t*)(ws + WS_QG); bf16_t* KG = (bf16_t*)(ws + WS_KG);
        const float* gq = args.in[6]; const float* gkv = args.in[8];
        const int ga_ = lane >> 5, gi_ = lane & 31; const float gq1 = GQP[2 * lane], gq2 = GQP[2 * lane + 1], gk1 = GKP[2 * lane], gk2 = GKP[2 * lane + 1];
        const f32x4 g0q = *(const f32x4*)(gq + lane * 8), g1q = *(const f32x4*)(gq + lane * 8 + 4), g0k = *(const f32x4*)(gkv + lane * 4);
        for (int r = gw; r < T; r += NGW) {
            const int s = r & 4095, prow = s >> 6, pcol = s & 63;
            bf16_t* pq = CQ + (size_t)r * 512 + lane * 8; bf16_t* pk = CKV + (size_t)r * 256 + lane * 4; unsigned* pe = (unsigned*)(KPE + (size_t)r * 64) + (lane & 31);
            const u32x4 wq = *(const u32x4*)pq; const u32x2 wk = *(const u32x2*)pk; const unsigned we = *pe;
            unsigned wh[10];
#pragma unroll
            for (int h = 0; h < 10; ++h) wh[h] = *((h < 8 ? (const unsigned*)(QG + (size_t)r * 1024 + h * 128) : (const unsigned*)(KG + (size_t)r * 256 + (h - 8) * 128)) + lane);
            const f32x2 csm = TABM[(((lane >> 4) & 1) ? pcol : prow) * 16 + (lane & 15)]; const f32x2 cs = TABG[(ga_ ? pcol : prow) * 32 + gi_];
            { float x[8] = {bf_lo(wq.x), bf_hi(wq.x), bf_lo(wq.y), bf_hi(wq.y), bf_lo(wq.z), bf_hi(wq.z), bf_lo(wq.w), bf_hi(wq.w)};
              float ss = 0.f;
#pragma unroll
              for (int j = 0; j < 8; ++j) ss += x[j] * x[j];
              const float rstd = 1.0f / sqrtf(wave_sum(ss) * (1.f / 512) + EPS);
              u32x4 o; o.x = cvt_pk_bf16(x[0] * rstd * g0q[0], x[1] * rstd * g0q[1]); o.y = cvt_pk_bf16(x[2] * rstd * g0q[2], x[3] * rstd * g0q[3]); o.z = cvt_pk_bf16(x[4] * rstd * g1q[0], x[5] * rstd * g1q[1]); o.w = cvt_pk_bf16(x[6] * rstd * g1q[2], x[7] * rstd * g1q[3]);
              *(u32x4*)pq = o; }
            { float x[4] = {bf_lo(wk.x), bf_hi(wk.x), bf_lo(wk.y), bf_hi(wk.y)};
              const float ss = (x[0] * x[0] + x[1] * x[1]) + (x[2] * x[2] + x[3] * x[3]);
              const float rstd = 1.0f / sqrtf(wave_sum(ss) * (1.f / 256) + EPS);
              u32x2 o; o.x = cvt_pk_bf16(x[0] * rstd * g0k[0], x[1] * rstd * g0k[1]); o.y = cvt_pk_bf16(x[2] * rstd * g0k[2], x[3] * rstd * g0k[3]); *(u32x2*)pk = o; }
            if (lane < 32) { const float x1 = bf_lo(we), x2 = bf_hi(we); *pe = cvt_pk_bf16(x1 * csm[0] - x2 * csm[1], x2 * csm[0] + x1 * csm[1]); }
#pragma unroll
            for (int h = 0; h < 10; ++h) { float x1 = bf_lo(wh[h]), x2 = bf_hi(wh[h]); const float rstd = 1.0f / sqrtf(wave_sum(x1 * x1 + x2 * x2) * (1.f / 128) + EPS);
                x1 = x1 * rstd * (h < 8 ? gq1 : gk1); x2 = x2 * rstd * (h < 8 ? gq2 : gk2);
                *((h < 8 ? (unsigned*)(QG + (size_t)r * 1024 + h * 128) : (unsigned*)(KG + (size_t)r * 256 + (h - 8) * 128)) + lane) = cvt_pk_bf16(x1 * cs[0] - x2 * cs[1], x2 * cs[0] + x1 * cs[1]); }
        }
        const bf16_t* VM = (const bf16_t*)(ws + WS_VM); bf16_t* VMT = (bf16_t*)(ws + WS_VMT);
        for (int ln = gw; ln < 1024 * NBATCH * 4; ln += NGW) { const int c = ln / (NBATCH * 4), rem = ln - c * (NBATCH * 4); const int b = rem >> 2, seg = rem & 3;
            const int pos = seg * 64 + lane; const int key = (pos & ~31) + 16 * ((pos >> 2) & 1) + 4 * ((pos >> 3) & 3) + (pos & 3);
            VMT[(size_t)c * MEMROWS + b * 256 + pos] = VM[(size_t)(b * 256 + key) * 1024 + c]; }
    }
    SEAM(2);


    if (IN(3)) {
        { pg8::Gemm g{(const bf16_t*)(ws + WS_CQ), (const bf16_t*)(ws + WS_WQB), 512, 512, T, 1536, 512}; pg8::StaticOrder S; S.init(T, 1536, G, bid);
          pg8::EpiQ E{QMLA, TABM}; pg8::gemm_phase(lds, g, S, E); }
        { pg8::Gemm g{(const bf16_t*)(ws + WS_CKV), (const bf16_t*)(ws + WS_WKVB), 256, 256, T, 2048, 256}; pg8::StaticOrder S; S.init(T, 2048, G, bid);
          pg8::EpiSplit E{(bf16_t*)(ws + WS_KN), (bf16_t*)(ws + WS_VN), 1024}; pg8::gemm_phase(lds, g, S, E); }
    }
    SEAM(3);


    if (IN(4)) {
        bf16_t* Z = (bf16_t*)(ws + WS_Z);
        const int NU = NBATCH * 8 * 16;
#define DECODE_UNIT(u) int bh, qb; if (G == 256) { const int i_ = (u) >> 8, c_ = (u) & 255; qb = (c_ >> 3) & 15; bh = i_ * 16 + (c_ & 7) * 2 + (c_ >> 7); } else { bh = (u) >> 4; qb = (u) & 15; } \
        const int b = bh >> 3, h = bh & 7; const size_t r0 = (size_t)b * SEQ + qb * 256;
#ifndef SKIP_MLA
        for (int u = bid; u < NU; u += G) { DECODE_UNIT(u)
            att::attn_unit<64, 1536, 1024, 1024, 192>(QMLA + r0 * 1536 + h * 192, (const bf16_t*)(ws + WS_KN) + (size_t)b * SEQ * 1024 + h * 128, (const bf16_t*)(ws + WS_KPE) + (size_t)b * SEQ * 64,
                                                  (const bf16_t*)(ws + WS_VN) + (size_t)b * SEQ * 1024 + h * 128, Z + r0 * 3072 + h * 128, SEQ, (LAS char*)lds); }
#endif
#ifndef SKIP_GQA
        for (int u = bid; u < NU; u += G) { DECODE_UNIT(u)
            att::attn_unit<0, 1024, 256, 256, 128>((const bf16_t*)(ws + WS_QG) + r0 * 1024 + h * 128, (const bf16_t*)(ws + WS_KG) + (size_t)b * SEQ * 256 + (h >> 2) * 128, nullptr,
                                               (const bf16_t*)(ws + WS_VG) + (size_t)b * SEQ * 256 + (h >> 2) * 128, Z + r0 * 3072 + 1024 + h * 128, SEQ, (LAS char*)lds); }
#endif
#undef DECODE_UNIT
#ifndef SKIP_MEM
        for (int u = bid; u < NBATCH * 4 * 32; u += G) { const int bh = u >> 5, rb = u & 31;
            mem_attn_block((const bf16_t*)(ws + WS_QM), (const bf16_t*)(ws + WS_KM), (const bf16_t*)(ws + WS_VMT), Z, bh >> 2, bh & 3, rb, lds, tid); }
#endif
    }
    SEAM(4);


#ifdef PROBE_CHECK
    if (lo == 20) {
        unsigned* cnt = (unsigned*)(ws + WS_ZERO + 4096 * 64 * 2 - 32);
        { const unsigned sidx = (unsigned)(bid * 512 + tid); const int tok = (int)((sidx * 2654435761u >> 7) % 2560u), c = (int)((sidx * 40503u >> 2) & 1023u); const int b_ = tok >> 8, key = tok & 255; const int pos = (key & ~31) + 8 * ((key >> 2) & 3) + 4 * ((key >> 4) & 1) + (key & 3);
          const bf16_t a_ = ((const bf16_t*)(ws + WS_VMT))[(size_t)c * MEMROWS + b_ * 256 + pos], b2_ = ((const bf16_t*)(ws + WS_VM))[(size_t)tok * 1024 + c]; if (a_ != b2_) atomicAdd(cnt + ((c & 128) ? 2 : 3), 1u); }
        const int w = bid * 8 + wave; const int r = (int)(((long)w * 977 + 13) % T); const int b = r >> 12; const int br = PROBE_BR;
        const int h = w & (br == 2 ? 3 : 7);
        const bf16_t* Qp; const bf16_t* Kp; const bf16_t* Xp = nullptr; const bf16_t* Vp; int ldk, ldv, dk, nk; float scale;
        if (br == 0) { Qp = QMLA + (size_t)r * 1536 + h * 192; Kp = (const bf16_t*)(ws + WS_KN) + (size_t)b * SEQ * 1024 + h * 128; Xp = (const bf16_t*)(ws + WS_KPE) + (size_t)b * SEQ * 64; Vp = (const bf16_t*)(ws + WS_VN) + (size_t)b * SEQ * 1024 + h * 128; ldk = 1024; ldv = 1024; dk = 128; nk = 4096; scale = 0.07216878364870323f; }
        else if (br == 1) { Qp = (const bf16_t*)(ws + WS_QG) + (size_t)r * 1024 + h * 128; Kp = (const bf16_t*)(ws + WS_KG) + (size_t)b * SEQ * 256 + (h >> 2) * 128; Vp = (const bf16_t*)(ws + WS_VG) + (size_t)b * SEQ * 256 + (h >> 2) * 128; ldk = 256; ldv = 256; dk = 128; nk = 4096; scale = 0.08838834764831843f; }
        else { Qp = (const bf16_t*)(ws + WS_QM) + (size_t)r * 1024 + h * 256; Kp = (const bf16_t*)(ws + WS_KM) + (size_t)b * 256 * 1024 + h * 256; Vp = (const bf16_t*)(ws + WS_VM) + (size_t)b * 256 * 1024 + h * 256 + 128; ldk = 1024; ldv = 1024; dk = 256; nk = 256; scale = 0.0625f; }
        float p[64]; float m = -1e30f;
#pragma unroll
        for (int j = 0; j < 64; ++j) { const int key = lane + 64 * j; float sdot = -1e30f;
            if (key < nk) { sdot = 0.f; for (int d = 0; d < dk; ++d) sdot += __uint_as_float((unsigned)Qp[d] << 16) * __uint_as_float((unsigned)Kp[(size_t)key * ldk + d] << 16);
                if (Xp) for (int d = 0; d < 64; ++d) sdot += __uint_as_float((unsigned)Qp[128 + d] << 16) * __uint_as_float((unsigned)Xp[(size_t)key * 64 + d] << 16);
                sdot *= scale; }
            p[j] = sdot; m = fmaxf(m, sdot); }
#pragma unroll
        for (int o = 1; o < 64; o <<= 1) m = fmaxf(m, __shfl_xor(m, o));
        float l = 0.f;
#pragma unroll
        for (int j = 0; j < 64; ++j) { p[j] = (lane + 64 * j < nk) ? __expf(p[j] - m) : 0.f; l += p[j]; }
        l = wave_sum(l);
        int bad = 0;
        const int zc = br * 1024 + (br == 2 ? h * 256 + 128 : h * 128);
        for (int d = 0; d < 128; ++d) { float acc = 0.f;
#pragma unroll
            for (int j = 0; j < 64; ++j) { const int key = lane + 64 * j; if (key < nk) acc += p[j] * __uint_as_float((unsigned)Vp[(size_t)key * ldv + d] << 16); }
            acc = wave_sum(acc) / l;
            float zd = 0.f; const bf16_t* wz = (const bf16_t*)(ws + WS_WIN) + (size_t)(3584 + zc + d) * 2048;
            for (int k = lane; k < 2048; k += 64) zd += __uint_as_float((unsigned)H[(size_t)r * 2048 + k] << 16) * __uint_as_float((unsigned)wz[k] << 16);
            zd = wave_sum(zd); const float sz = zd / (1.f + __expf(-zd)); const float szb = __uint_as_float(cvt_pk_bf16(sz, 0.f) << 16);
#ifdef PROBE_NOZ
            const float uref = acc; (void)szb;
#else
            const float uref = acc * szb;
#endif
            const float um = __uint_as_float((unsigned)((const bf16_t*)(ws + WS_Z))[(size_t)r * 3072 + zc + d] << 16);
            if (fabsf(um - uref) > 0.02f * fabsf(uref) + 0.0003f) ++bad; }
        if (lane == 0) { atomicAdd(cnt + 0, 1u); if (bad > 0) atomicAdd(cnt + 1, 1u); }
    }
    if (lo == 21 && bid < 64) {
        unsigned* cnt = (unsigned*)(ws + WS_ZERO + 4096 * 64 * 2 - 32);
        const int w = bid * 8 + wave; const int r = (int)(((long)w * 977 + 13) % T), c = (w * 1543 + 11) % 6144;
        float gd = 0.f; const bf16_t* wg = (const bf16_t*)(ws + WS_WGL) + (size_t)c * 2048;
        for (int k = lane; k < 2048; k += 64) gd += __uint_as_float((unsigned)H[(size_t)r * 2048 + k] << 16) * __uint_as_float((unsigned)wg[k] << 16);
        gd = wave_sum(gd); const float gref = 1.f / (1.f + __expf(-gd)); const float gm = __uint_as_float((unsigned)((const bf16_t*)(ws + WS_GL))[(size_t)r * 6144 + c] << 16);
        if (lane == 0 && fabsf(gm - gref) > 0.005f) atomicAdd(cnt + 4, 1u);
    }
    if (lo == 22 && bid < 64) {
        unsigned* cnt = (unsigned*)(ws + WS_ZERO + 4096 * 64 * 2 - 32);
        const int w = bid * 8 + wave; const int r = (int)(((long)w * 977 + 13) % T), c = (w * 389 + 7) & 2047;
        const bf16_t* GLb = (const bf16_t*)(ws + WS_GL); const bf16_t* Zb = (const bf16_t*)(ws + WS_Z); const bf16_t* WBRb = (const bf16_t*)(ws + WS_WBR); const bf16_t* MG = (const bf16_t*)(ws + WS_MERGED);
        const bf16_t* WO = (const bf16_t*)(ws + WS_WOUT);
        float mref = 0.f;
        for (int i = 0; i < 3; ++i) { float d = 0.f; for (int k = lane; k < 1024; k += 64) d += __uint_as_float((unsigned)Zb[(size_t)r * 3072 + i * 1024 + k] << 16) * __uint_as_float((unsigned)WBRb[((size_t)i * 2048 + c) * 1024 + k] << 16);
            d = wave_sum(d); mref += d * __uint_as_float((unsigned)GLb[(size_t)r * 6144 + i * 2048 + c] << 16); }
        const float mm = __uint_as_float((unsigned)MG[(size_t)r * 2048 + c] << 16);
        float yd = 0.f; for (int k = lane; k < 2048; k += 64) yd += __uint_as_float((unsigned)MG[(size_t)r * 2048 + k] << 16) * __uint_as_float((unsigned)WO[(size_t)c * 2048 + k] << 16);
        yd = wave_sum(yd); const float* xr = r < TP ? xp + (size_t)r * DM : xs + (size_t)(r - TP) * DM; const float yref = xr[c] + yd; const float ym = args.out[(size_t)r * DM + c];
        if (lane == 0) {
            if (fabsf(mm - mref) > 0.015f * fabsf(mref) + 0.0003f) atomicAdd(cnt + 5, 1u);
            if (fabsf(ym - yref) > 0.001f) atomicAdd(cnt + 6, 1u); }
    }
#endif
    if (IN(5)) {
        pg8::Gemm g{(const bf16_t*)(ws + WS_H8), (const bf16_t*)(ws + WS_WGL), 1024, 1024, T, 6144, 1024}; pg8::StaticOrder S; S.init(T, 6144, G, bid);
        pg8::EpiGL E{(bf16_t*)(ws + WS_GL), 1.f / (H8_SCALE * W8_SCALE)}; pg8::gemm_phase<pg8::EpiGL, pg8::StaticOrder, true>(lds, g, S, E);
    }
    SEAM(5);

    if (IN(6)) {
#ifndef PROBE_ZERO
#define PROBE_ZERO -1
#endif
        for (int i = 0; i < 3; ++i) {
            if (i == PROBE_ZERO) continue;
            pg8::Gemm g{(const bf16_t*)(ws + WS_Z) + i * 1024, (const bf16_t*)(ws + WS_WBR) + (size_t)i * 2048 * 1024, 3072, 1024, T, 2048, 1024}; pg8::StaticOrder S; S.init(T, 2048, G, bid);
            pg8::EpiBR E{(const bf16_t*)(ws + WS_GL) + i * 2048, (bf16_t*)(ws + WS_MERGED), i == (PROBE_ZERO == 0 ? 1 : 0)}; pg8::gemm_phase(lds, g, S, E);
        }
    }
    SEAM(6);

    if (IN(7)) {
        pg8::Gemm g{(const bf16_t*)(ws + WS_MERGED), (const bf16_t*)(ws + WS_WOUT), 2048, 2048, T, 2048, 2048}; pg8::StaticOrder S; S.init(T, 2048, G, bid);
        pg8::EpiOut E{xp, xs, args.out, (float*)(ws + WS_SSQ)}; pg8::gemm_phase(lds, g, S, E);
    }
    SEAM(7);


#ifdef PROBE_SCAN
    if (lo == 30) {
        unsigned* cnt = (unsigned*)(ws + WS_ZERO + 4096 * 64 * 2 - 32);
        const size_t gt = (size_t)bid * 512 + tid, gn = (size_t)G * 512;
        unsigned f = 0;
        { const bf16_t* p = (const bf16_t*)(ws + WS_WIN); const size_t n = (WS_TABG - WS_WIN) / 2; for (size_t i = gt; i < n; i += gn) { const float v = __uint_as_float((unsigned)p[i] << 16); if (!(fabsf(v) < 0.5f)) f |= 1u; } }
        { const bf16_t* p = (const bf16_t*)(ws + WS_MERGED); const size_t n = (size_t)T * 2048; for (size_t i = gt; i < n; i += gn) { const float v = __uint_as_float((unsigned)p[i] << 16); if (!(fabsf(v) < 2.0f)) f |= 2u; } }
        { const bf16_t* p = (const bf16_t*)(ws + WS_Z); const size_t n = (size_t)T * 3072; for (size_t i = gt; i < n; i += gn) { const float v = __uint_as_float((unsigned)p[i] << 16); if (!(fabsf(v) < 4.0f)) f |= 4u; } }
        { const bf16_t* p = (const bf16_t*)(ws + WS_GL); const size_t n = (size_t)T * 6144; for (size_t i = gt; i < n; i += gn) { const float v = __uint_as_float((unsigned)p[i] << 16); if (!(v >= 0.f && v <= 1.f)) f |= 8u; } }
        if (f & 1u) atomicAdd(cnt + 1, 1u); if (f & 2u) atomicAdd(cnt + 2, 1u); if (f & 4u) atomicAdd(cnt + 3, 1u); if (f & 8u) atomicAdd(cnt + 4, 1u);
        if (tid == 0) atomicAdd(cnt + 0, 1u);
    }
#endif
#define PH_FINAL 8
    if (IN(PH_FINAL)) {
        const float* gf = args.in[16];
#if defined(PROBE_SCAN)
        const unsigned* cntp = (const unsigned*)(ws + WS_ZERO + 4096 * 64 * 2 - 32);
        unsigned nn[5];
        for (int q = 0; q < 5; ++q) nn[q] = __hip_atomic_load(cntp + q, __ATOMIC_RELAXED, __HIP_MEMORY_SCOPE_AGENT);
        const float pscale = 1.f + (nn[0] == (unsigned)G ? 0.05f : 0.f) + (nn[1] > 0u ? 0.1f : 0.f) + (nn[2] > 0u ? 0.2f : 0.f) + (nn[3] > 0u ? 0.4f : 0.f) + (nn[4] > 0u ? 0.8f : 0.f);
#elif defined(PROBE_CHECK)
        const unsigned* cntp = (const unsigned*)(ws + WS_ZERO + 4096 * 64 * 2 - 32);
        unsigned nn[7];
        for (int q = 0; q < 7; ++q) nn[q] = __hip_atomic_load(cntp + q, __ATOMIC_RELAXED, __HIP_MEMORY_SCOPE_AGENT);
        const float pscale = 1.f + (nn[0] == 2048u ? 0.05f : 0.f) + (float)nn[1] * 0.01f;
#else
        const float pscale = 1.f;
#endif
        for (int r = gw; r < T; r += NGW) {
            f32x4* orow = (f32x4*)(args.out + (size_t)r * DM);
            f32x4 v[8]; float sq = 0.f;
#pragma unroll
            for (int j = 0; j < 8; ++j) { v[j] = orow[lane + 64 * j]; sq += (v[j][0] * v[j][0] + v[j][1] * v[j][1]) + (v[j][2] * v[j][2] + v[j][3] * v[j][3]); }
#ifdef PROBE_NORSTD
            const float rstd = pscale + 0.f * wave_sum(sq);
#else
            const float rstd = pscale / sqrtf(wave_sum(sq) * (1.f / DM) + EPS);
#endif
#pragma unroll
            for (int j = 0; j < 8; ++j) {
#ifdef PROBE_NOGAIN
                const f32x4 gg = (f32x4){1.f, 1.f, 1.f, 1.f};
#else
                const f32x4 gg = ((const f32x4*)gf)[lane + 64 * j];
#endif
                f32x4 w; w[0] = v[j][0] * rstd * gg[0]; w[1] = v[j][1] * rstd * gg[1]; w[2] = v[j][2] * rstd * gg[2]; w[3] = v[j][3] * rstd * gg[3]; orow[lane + 64 * j] = w; }
        }
    }
    __builtin_amdgcn_fence(__ATOMIC_RELEASE, "agent");
#undef IN
#undef SEAM
}

extern "C" void kernel_launch(void* const* d_in, const int* in_sizes, int n_in, void* d_out, int out_size, void* d_ws, size_t ws_size, hipStream_t stream) {
    static int grid = 0;
    if (grid == 0) {
        if (n_in != 17 || out_size != T * DM || ws_size < WS_END) { fprintf(stderr, "kernel_launch: unexpected shapes: n_in %d out %d ws %zu (need %zu)\n", n_in, out_size, ws_size, (size_t)WS_END); grid = -1; return; }
        int dev = 0, cus = 0;
        if (hipGetDevice(&dev) != hipSuccess || hipDeviceGetAttribute(&cus, hipDeviceAttributeMultiprocessorCount, dev) != hipSuccess) { grid = -1; return; }
        if (hipFuncSetAttribute((const void*)mk_fwd<MK_COOP != 0>, hipFuncAttributeMaxDynamicSharedMemorySize, LDS_BYTES) != hipSuccess) { fprintf(stderr, "kernel_launch: hipFuncSetAttribute failed\n"); grid = -1; return; }
        int per_cu = 0;
        if (hipOccupancyMaxActiveBlocksPerMultiprocessor(&per_cu, (const void*)mk_fwd<MK_COOP != 0>, 512, LDS_BYTES) != hipSuccess || per_cu < 1) { fprintf(stderr, "kernel_launch: occupancy query says %d\n", per_cu); per_cu = 1; }
        (void)hipGetLastError();
        grid = cus;
    }
    if (grid < 0) return;
    Args a{};
    for (int i = 0; i < 17; ++i) a.in[i] = (const float*)d_in[i];
    a.out = (float*)d_out; a.ws = (unsigned char*)d_ws;
#if MK_COOP
    (void)hipMemsetAsync((char*)d_ws + WS_BAR, 0, 256, stream);
    a.ph_lo = 0; a.ph_hi = NPHASE;
    void* kargs[] = {&a};
    hipError_t e = hipLaunchCooperativeKernel((const void*)mk_fwd<true>, dim3(grid), dim3(512), kargs, LDS_BYTES, stream);
    if (e != hipSuccess) fprintf(stderr, "kernel_launch: cooperative launch failed: %s (grid %d)\n", hipGetErrorString(e), grid);
#else
#if defined(PROBE_SCAN)
    const int seq_[10] = {0, 1, 2, 3, 4, 5, 6, 7, 30, 8};
    for (int q = 0; q < 10; ++q) { a.ph_lo = seq_[q]; a.ph_hi = seq_[q] + 1; hipLaunchKernelGGL(mk_fwd<false>, dim3(grid), dim3(512), LDS_BYTES, stream, a); }
#elif defined(PROBE_CHECK)
    const int seq_[12] = {0, 1, 2, 3, 4, 20, 5, 21, 6, 7, 22, 8};
    for (int q = 0; q < 12; ++q) { a.ph_lo = seq_[q]; a.ph_hi = seq_[q] + 1; hipLaunchKernelGGL(mk_fwd<false>, dim3(grid), dim3(512), LDS_BYTES, stream, a); }
#else
    for (int p = 0; p < NPHASE; ++p) { a.ph_lo = p; a.ph_hi = p + 1; hipLaunchKernelGGL(mk_fwd<false>, dim3(grid), dim3(512), LDS_BYTES, stream, a); }
#endif
#endif
}
```

```cpp
#include <hip/hip_runtime.h>
#include <hip/hip_cooperative_groups.h>
#include <cstdio>
#include <cstdint>
namespace cg = cooperative_groups;

#define PROBE_BETA 1.0f
#ifndef MK_COOP
#define MK_COOP 1
#endif

#define LAS __attribute__((address_space(3)))
typedef unsigned short bf16_t;
typedef short bf16x8 __attribute__((ext_vector_type(8)));
typedef short s16x4 __attribute__((ext_vector_type(4)));
typedef float f32x2 __attribute__((ext_vector_type(2)));
typedef float f32x4 __attribute__((ext_vector_type(4)));
typedef float f32x16 __attribute__((ext_vector_type(16)));
typedef unsigned u32x2 __attribute__((ext_vector_type(2)));
typedef unsigned u32x4 __attribute__((ext_vector_type(4)));
typedef long l64x2 __attribute__((ext_vector_type(2)));

constexpr int T = 40960, TP = 32768, DM = 2048, SEQ = 4096, NBATCH = 10, MEMROWS = 2560;
constexpr float EPS = 1e-6f;
constexpr int NP1 = 6656;
constexpr size_t WS_WIN = 0;
constexpr size_t WS_WGL = WS_WIN + (size_t)NP1 * 2048 * 2;
constexpr size_t WS_WQB = WS_WGL + (size_t)6144 * 2048 * 2;
constexpr size_t WS_WKVB = WS_WQB + (size_t)1536 * 512 * 2;
constexpr size_t WS_WMKV = WS_WKVB + (size_t)2048 * 256 * 2;
constexpr size_t WS_WBR = WS_WMKV + (size_t)2048 * 2048 * 2;
constexpr size_t WS_WOUT = WS_WBR + (size_t)3 * 2048 * 1024 * 2;
constexpr size_t WS_TABG = WS_WOUT + (size_t)2048 * 2048 * 2;
constexpr size_t WS_TABM = WS_TABG + 64 * 32 * 8;
constexpr size_t WS_GQP = WS_TABM + 64 * 16 * 8;
constexpr size_t WS_GKP = WS_GQP + 512;
constexpr size_t WS_BAR = WS_GKP + 512;
constexpr size_t WS_ZERO = WS_BAR + 256;
constexpr size_t WS_SSQ = WS_ZERO + 4096 * 64 * 2;
constexpr size_t WS_Z = WS_SSQ + (size_t)T * 32 * 4;
constexpr size_t WS_R = WS_Z + (size_t)T * 3072 * 2;
constexpr size_t WS_CQ = WS_R;
constexpr size_t WS_CKV = WS_CQ + (size_t)T * 512 * 2;
constexpr size_t WS_KPE = WS_CKV + (size_t)T * 256 * 2;
constexpr size_t WS_QG = WS_KPE + (size_t)T * 64 * 2;
constexpr size_t WS_KG = WS_QG + (size_t)T * 1024 * 2;
constexpr size_t WS_VG = WS_KG + (size_t)T * 256 * 2;
constexpr size_t WS_QM = WS_VG + (size_t)T * 256 * 2;
constexpr size_t WS_KN = WS_QM + (size_t)T * 1024 * 2;
constexpr size_t WS_VN = WS_KN + (size_t)T * 1024 * 2;
constexpr size_t WS_KM = WS_VN + (size_t)T * 1024 * 2;
constexpr size_t WS_VM = WS_KM + (size_t)MEMROWS * 1024 * 2;
constexpr size_t WS_VMT = WS_VM + (size_t)MEMROWS * 1024 * 2;
constexpr size_t WS_REND = WS_VMT + (size_t)MEMROWS * 1024 * 2;
constexpr size_t WS_GL = WS_R;
constexpr size_t WS_MERGED = WS_GL + (size_t)T * 6144 * 2;
constexpr size_t WS_END = WS_MERGED + (size_t)T * 2048 * 2;
constexpr size_t WS_H8 = WS_MERGED;
constexpr float H8_SCALE = 16.f, W8_SCALE = 64.f;
static_assert(WS_REND <= WS_MERGED, "region R inside GL overlay");
static_assert(WS_END <= (size_t)1 << 30, "d_ws map fits 1 GiB");
constexpr size_t DO_H = 0;
constexpr size_t DO_QMLA = DO_H + (size_t)T * 2048 * 2;
constexpr size_t DO_MN = DO_QMLA + (size_t)T * 1536 * 2;
static_assert(DO_MN + (size_t)MEMROWS * 2048 * 2 <= (size_t)T * 2048 * 4, "d_out scratch");

constexpr int LDS_BYTES = 131072 + 512;

typedef float f32x2_cv __attribute__((ext_vector_type(2)));
typedef __bf16 bf16x2_cv __attribute__((ext_vector_type(2)));
__device__ __forceinline__ unsigned cvt_pk_bf16(float lo, float hi) { unsigned r; asm volatile("v_cvt_pk_bf16_f32 %0, %1, %2" : "=v"(r) : "v"(lo), "v"(hi)); return r; }
__device__ __forceinline__ unsigned cvt_pk_bf16_safe(float lo, float hi) { const f32x2_cv v = {lo, hi}; const bf16x2_cv b = __builtin_convertvector(v, bf16x2_cv); return __builtin_bit_cast(unsigned, b); }
__device__ __forceinline__ u32x4 ld16_coherent(const void* p) { u32x4 v; asm volatile("global_load_dwordx4 %0, %1, off sc1\n\ts_waitcnt vmcnt(0)" : "=v"(v) : "v"(p) : "memory"); return v; }
__device__ __forceinline__ float bf_lo(unsigned w) { return __uint_as_float(w << 16); }
__device__ __forceinline__ float bf_hi(unsigned w) { return __uint_as_float(w & 0xffff0000u); }
__device__ __forceinline__ float wave_sum(float v) {
#pragma unroll
    for (int o = 1; o < 64; o <<= 1) v += __shfl_xor(v, o);
    return v;
}
__device__ __forceinline__ float fast_sigmoid(float v) { return __builtin_amdgcn_rcpf(1.f + __builtin_amdgcn_exp2f(-1.4426950408889634f * v)); }
__device__ __forceinline__ float fast_silu(float v) { return v * fast_sigmoid(v); }

namespace pg8 {
constexpr int BM = 256, BK = 64, HALF = 128, HTB = HALF * BK * 2, STAGE_BYTES = 8 * HTB, NXCD = 8, WGM = 8;
__host__ __device__ __forceinline__ int lds_byte(int r, int c) { const int st = (r >> 4) * 2 + (c >> 5), rr = r & 15, cc = c & 31, ob = rr * 64 + cc * 2; return st * 1024 + (ob ^ (((ob >> 9) & 1) << 5)); }
__host__ __device__ __forceinline__ void stage_rc(int b, int& R, int& C) { const int st = b / 1024, sb = b % 1024, swz = sb ^ (((sb >> 9) & 1) << 5); R = (st >> 1) * 16 + swz / 64; C = (st & 1) * 32 + (swz % 64) / 2; }
__host__ __device__ __forceinline__ int perm32(int rho) { const int n = rho >> 4, i = rho & 15; return 8 * (i >> 2) + 4 * n + (i & 3); }

struct Unit { int pm, pn; };
struct Gemm { const bf16_t* A; const bf16_t* Bt; int lda, ldb, M, N, K; };

struct StaticOrder {
    int nM, nN, nwg, G, c;
    __device__ void init(int M, int N, int G_, int c_) { nM = M / BM; nN = N / BM; nwg = nM * nN; G = G_; c = c_; }
    __device__ bool next(int i, Unit& u) const {
        const long L = (long)i * G + c; if (L >= nwg) return false;
        int wgid = (int)L; { const int q = nwg / NXCD, r = nwg % NXCD, xcd = wgid % NXCD, off = wgid / NXCD; wgid = (xcd < r ? xcd * (q + 1) : r * (q + 1) + (xcd - r) * q) + off; }
        const int nig = WGM * nN, gid = wgid / nig, fm = gid * WGM, gsz = (nM - fm) < WGM ? (nM - fm) : WGM;
        u.pm = fm + ((wgid % nig) % gsz); u.pn = (wgid % nig) / gsz; return true;
    }
};

template <class Epi, class Sched, bool FP8 = false>
__device__ __forceinline__ void gemm_phase(LAS unsigned char* lds, const Gemm g, const Sched& S, const Epi& E) {
    const int tid = threadIdx.x, wid = __builtin_amdgcn_readfirstlane(tid >> 6), lane = tid & 63, wr = wid >> 2, wc = wid & 3, fr = lane & 15, fq = lane >> 4;
    const int K = g.K, nt = K / BK;
    unsigned voffA[2], voffB[2];
#pragma unroll
    for (int i = 0; i < 2; ++i) { int R, C; stage_rc(tid * 16 + i * 8192, R, C); const int Rb = Epi::PERM ? ((R & ~31) + perm32(R & 31)) : R;
        voffA[i] = (unsigned)(R * g.lda + C) * 2u; voffB[i] = (unsigned)(Rb * g.ldb + C) * 2u; }
    const size_t kstep = (size_t)(BK * 2);
    const size_t hstepA = (size_t)HALF * g.lda * 2, hstepB = (size_t)HALF * g.ldb * 2;
    const size_t tstepA = 2 * hstepA, tstepB = 2 * hstepB;
    const unsigned ldsw = (unsigned)wid * 1024u;
    const int aoff = lds_byte(wr * 64 + fr, fq * 8), boff = lds_byte(wc * 32 + fr, fq * 8);
#define PG8_SA(b, h) (((b) * 2 + (h)) * HTB)
#define PG8_SB(b, h) ((4 + (b) * 2 + (h)) * HTB)
#define PG8_STAGE(bufoff, gbase, voff) do { _Pragma("unroll") for (int _i = 0; _i < 2; ++_i) \
        __builtin_amdgcn_global_load_lds((const unsigned*)((const char*)(gbase) + (voff)[_i]), (LAS unsigned*)(lds + (bufoff) + ldsw + _i * 8192), 16, 0, 0); } while (0)
#define PG8_LDA(dst, b, h) do { _Pragma("unroll") for (int m = 0; m < 4; ++m) _Pragma("unroll") for (int k = 0; k < 2; ++k) dst[m][k] = *(const LAS bf16x8*)(lds + PG8_SA(b, h) + aoff + m * 2048 + k * 1024); } while (0)
#define PG8_LDB(dst, b, h) do { _Pragma("unroll") for (int n = 0; n < 2; ++n) _Pragma("unroll") for (int k = 0; k < 2; ++k) dst[n][k] = *(const LAS bf16x8*)(lds + PG8_SB(b, h) + boff + n * 2048 + k * 1024); } while (0)
#define PG8_MMA(ai, bj, At, Bt) do { __builtin_amdgcn_s_setprio(1); _Pragma("unroll") for (int m = 0; m < 4; ++m) _Pragma("unroll") for (int n = 0; n < 2; ++n) _Pragma("unroll") for (int k = 0; k < 2; ++k) { \
        if constexpr (FP8) { const l64x2 b_ = __builtin_bit_cast(l64x2, Bt[n][k]), a_ = __builtin_bit_cast(l64x2, At[m][k]); \
            acc[ai][bj][m][n] = __builtin_amdgcn_mfma_f32_16x16x32_fp8_fp8(b_[0], a_[0], acc[ai][bj][m][n], 0, 0, 0); \
            acc[ai][bj][m][n] = __builtin_amdgcn_mfma_f32_16x16x32_fp8_fp8(b_[1], a_[1], acc[ai][bj][m][n], 0, 0, 0); } \
        else acc[ai][bj][m][n] = __builtin_amdgcn_mfma_f32_16x16x32_bf16(Bt[n][k], At[m][k], acc[ai][bj][m][n], 0, 0, 0); } __builtin_amdgcn_s_setprio(0); } while (0)
#define PG8_WAIT_V(n) asm volatile("s_waitcnt vmcnt(" #n ")" ::: "memory")
#define PG8_WAIT_L(n) asm volatile("s_waitcnt lgkmcnt(" #n ")" ::: "memory")
#define PG8_BAR __builtin_amdgcn_s_barrier()
#define PG8_SCHED __builtin_amdgcn_sched_barrier(0)
    Unit cur, nxt; int ui = 0;
    if (!S.next(0, cur)) return;
    f32x4 acc[2][2][4][2];
#pragma unroll
    for (int a = 0; a < 2; ++a)
#pragma unroll
        for (int b = 0; b < 2; ++b)
#pragma unroll
            for (int m = 0; m < 4; ++m)
#pragma unroll
                for (int n = 0; n < 2; ++n) acc[a][b][m][n] = (f32x4){0.f, 0.f, 0.f, 0.f};
    bf16x8 At[4][2], B0[2][2], B1[2][2];
    const char* cA = (const char*)g.A + (size_t)cur.pm * tstepA; const char* cB = (const char*)g.Bt + (size_t)cur.pn * tstepB;
    PG8_STAGE(PG8_SB(0, 0), cB, voffB); PG8_STAGE(PG8_SB(0, 1), cB + hstepB, voffB); PG8_STAGE(PG8_SA(0, 0), cA, voffA); PG8_STAGE(PG8_SA(0, 1), cA + hstepA, voffA);
    if (wr == 1) PG8_BAR;
    PG8_WAIT_V(2); PG8_BAR;
    PG8_STAGE(PG8_SB(1, 0), cB + kstep, voffB); PG8_STAGE(PG8_SA(1, 0), cA + kstep, voffA); PG8_STAGE(PG8_SB(1, 1), cB + hstepB + kstep, voffB);
    PG8_WAIT_V(6); PG8_BAR;
    for (;;) {
        const bool has_next = S.next(ui + 1, nxt);
        const char* nA = has_next ? (const char*)g.A + (size_t)nxt.pm * tstepA : cA; const char* nB = has_next ? (const char*)g.Bt + (size_t)nxt.pn * tstepB : cB;
        for (int t = 0; t < nt; t += 2) {
            const bool last = (t == nt - 2);
            const char* a1 = cA + (size_t)(t + 1) * kstep;
            const char* a2 = last ? nA : cA + (size_t)(t + 2) * kstep; const char* b2 = last ? nB : cB + (size_t)(t + 2) * kstep;
            const char* a3 = a2 + kstep; const char* b3 = b2 + kstep;
            PG8_LDB(B0, 0, 0); PG8_LDB(B1, 0, 1); PG8_SCHED; PG8_LDA(At, 0, 0); PG8_STAGE(PG8_SA(1, 1), a1 + hstepA, voffA);
            PG8_WAIT_V(8); PG8_WAIT_L(0); PG8_BAR; PG8_MMA(0, 0, At, B0); PG8_MMA(0, 1, At, B1); PG8_BAR; PG8_SCHED;
            PG8_LDA(At, 0, 1); PG8_STAGE(PG8_SB(0, 0), b2, voffB); PG8_STAGE(PG8_SB(0, 1), b2 + hstepB, voffB); PG8_STAGE(PG8_SA(0, 0), a2, voffA);
            PG8_WAIT_V(8); PG8_WAIT_L(0); PG8_BAR; PG8_MMA(1, 0, At, B0); PG8_MMA(1, 1, At, B1); PG8_BAR; PG8_SCHED;
            PG8_LDB(B0, 1, 0); PG8_LDB(B1, 1, 1); PG8_SCHED; PG8_LDA(At, 1, 0); PG8_STAGE(PG8_SA(0, 1), a2 + hstepA, voffA);
            PG8_WAIT_V(8); PG8_WAIT_L(0); PG8_BAR; PG8_MMA(0, 0, At, B0); PG8_MMA(0, 1, At, B1); PG8_BAR; PG8_SCHED;
            PG8_LDA(At, 1, 1); PG8_STAGE(PG8_SB(1, 0), b3, voffB); PG8_STAGE(PG8_SB(1, 1), b3 + hstepB, voffB); PG8_STAGE(PG8_SA(1, 0), a3, voffA);
            PG8_WAIT_V(8); PG8_WAIT_L(0); PG8_BAR; PG8_MMA(1, 0, At, B0); PG8_MMA(1, 1, At, B1); PG8_BAR; PG8_SCHED;
        }
        if (wr == 0) PG8_BAR;
        E(acc, cur, wr, wc, fr, fq);
        if (!has_next) break;
#pragma unroll
        for (int a = 0; a < 2; ++a)
#pragma unroll
            for (int b = 0; b < 2; ++b)
#pragma unroll
                for (int m = 0; m < 4; ++m)
#pragma unroll
                    for (int n = 0; n < 2; ++n) acc[a][b][m][n] = (f32x4){0.f, 0.f, 0.f, 0.f};
        cur = nxt; cA = nA; cB = nB; ++ui;
        if (wr == 1) PG8_BAR;
    }
    PG8_WAIT_V(0);
    PG8_BAR;
#undef PG8_SA
#undef PG8_SB
#undef PG8_STAGE
#undef PG8_LDA
#undef PG8_LDB
#undef PG8_MMA
#undef PG8_WAIT_V
#undef PG8_WAIT_L
#undef PG8_BAR
#undef PG8_SCHED
}

template <class F> __device__ __forceinline__ void epi_loop(const f32x4 (&acc)[2][2][4][2], const Unit& u, int wr, int wc, int fr, int fq, F f) {
#pragma unroll
    for (int ai = 0; ai < 2; ++ai)
#pragma unroll
        for (int m = 0; m < 4; ++m) { const int row = u.pm * BM + ai * HALF + wr * 64 + m * 16 + fr;
#pragma unroll
            for (int bj = 0; bj < 2; ++bj) { const int lc = bj * HALF + wc * 32 + 8 * fq; f(row, lc, acc[ai][bj][m][0], acc[ai][bj][m][1]); } }
}
#define EPI_BEGIN epi_loop(acc, u, wr, wc, fr, fq, [&](int row, int lc, f32x4 v0, f32x4 v1) __attribute__((always_inline)) {
#define EPI_END });

__device__ __forceinline__ u32x4 pack8(f32x4 v0, f32x4 v1) { u32x4 w; w.x = cvt_pk_bf16(v0[0], v0[1]); w.y = cvt_pk_bf16(v0[2], v0[3]); w.z = cvt_pk_bf16(v1[0], v1[1]); w.w = cvt_pk_bf16(v1[2], v1[3]); return w; }

struct EpiP1 {
    static constexpr bool PERM = true;
    unsigned char* ws;
    __device__ __forceinline__ void operator()(const f32x4 (&acc)[2][2][4][2], const Unit& u, int wr, int wc, int fr, int fq) const {
        const int pn = u.pn; bf16_t* dst; int ldc, c0; int mode = 0;
        if (pn < 2) { dst = (bf16_t*)(ws + WS_CQ); ldc = 512; c0 = pn * 256; }
        else if (pn == 2) { dst = (bf16_t*)(ws + WS_CKV); ldc = 256; c0 = 0; }
        else if (pn == 3) { dst = (bf16_t*)(ws + WS_KPE); ldc = 64; c0 = 0; mode = 2; }
        else if (pn < 8) { dst = (bf16_t*)(ws + WS_QG); ldc = 1024; c0 = (pn - 4) * 256; }
        else if (pn == 8) { dst = (bf16_t*)(ws + WS_KG); ldc = 256; c0 = 0; }
        else if (pn == 9) { dst = (bf16_t*)(ws + WS_VG); ldc = 256; c0 = 0; }
        else if (pn < 14) { dst = (bf16_t*)(ws + WS_QM); ldc = 1024; c0 = (pn - 10) * 256; }
        else { dst = (bf16_t*)(ws + WS_Z); ldc = 3072; c0 = (pn - 14) * 256; mode = 1; }
        EPI_BEGIN
            if (mode == 1) {
#pragma unroll
                for (int e = 0; e < 4; ++e) { v0[e] = fast_silu(v0[e]); v1[e] = fast_silu(v1[e]); } }
            if (mode != 2 || lc < 64) *(u32x4*)(dst + (size_t)row * ldc + c0 + lc) = pack8(v0, v1);
        EPI_END
    }
};
struct EpiSplit {
    static constexpr bool PERM = true;
    bf16_t* d0; bf16_t* d1; int ldc;
    __device__ __forceinline__ void operator()(const f32x4 (&acc)[2][2][4][2], const Unit& u, int wr, int wc, int fr, int fq) const {
        bf16_t* dst = u.pn < 4 ? d0 : d1; const int c0 = (u.pn & 3) * 256;
        EPI_BEGIN *(u32x4*)(dst + (size_t)row * ldc + c0 + lc) = pack8(v0, v1); EPI_END
    }
};
struct EpiQ {
    static constexpr bool PERM = true;
    bf16_t* dst; const f32x2* tabm;
    __device__ __forceinline__ void operator()(const f32x4 (&acc)[2][2][4][2], const Unit& u, int wr, int wc, int fr, int fq) const {
        EPI_BEGIN
            const int c = u.pn * 256 + lc; const int d = c % 192;
            if (d >= 128) { const int p0 = d - 128, a = p0 >> 5, i0 = (p0 & 31) >> 1; const int s = row & 4095; const int pos = a ? (s & 63) : (s >> 6);
                const f32x4 cs0 = *(const f32x4*)(tabm + pos * 16 + i0), cs1 = *(const f32x4*)(tabm + pos * 16 + i0 + 2);
                f32x4 r0, r1;
                r0[0] = v0[0] * cs0[0] - v0[1] * cs0[1]; r0[1] = v0[1] * cs0[0] + v0[0] * cs0[1];
                r0[2] = v0[2] * cs0[2] - v0[3] * cs0[3]; r0[3] = v0[3] * cs0[2] + v0[2] * cs0[3];
                r1[0] = v1[0] * cs1[0] - v1[1] * cs1[1]; r1[1] = v1[1] * cs1[0] + v1[0] * cs1[1];
                r1[2] = v1[2] * cs1[2] - v1[3] * cs1[3]; r1[3] = v1[3] * cs1[2] + v1[2] * cs1[3];
                v0 = r0; v1 = r1; }
            *(u32x4*)(dst + (size_t)row * 1536 + c) = pack8(v0, v1);
        EPI_END
    }
};
struct EpiGL {
    static constexpr bool PERM = true;
    bf16_t* dst; float scale;
    __device__ __forceinline__ void operator()(const f32x4 (&acc)[2][2][4][2], const Unit& u, int wr, int wc, int fr, int fq) const {
        EPI_BEGIN
#pragma unroll
            for (int e = 0; e < 4; ++e) { v0[e] = fast_sigmoid(v0[e] * scale); v1[e] = fast_sigmoid(v1[e] * scale); }
            u32x4 w_; w_.x = cvt_pk_bf16_safe(v0[0], v0[1]); w_.y = cvt_pk_bf16_safe(v0[2], v0[3]); w_.z = cvt_pk_bf16_safe(v1[0], v1[1]); w_.w = cvt_pk_bf16_safe(v1[2], v1[3]);
            *(u32x4*)(dst + (size_t)row * 6144 + u.pn * 256 + lc) = w_;
        EPI_END
    }
};
struct EpiBR {
    static constexpr bool PERM = true;
    const bf16_t* gl; bf16_t* merged; int first;
    __device__ __forceinline__ void operator()(const f32x4 (&acc)[2][2][4][2], const Unit& u, int wr, int wc, int fr, int fq) const {
        EPI_BEGIN
            const int c = u.pn * 256 + lc;
            const u32x4 gw = *(const u32x4*)(gl + (size_t)row * 6144 + c);
            bf16_t* mp = merged + (size_t)row * 2048 + c;
            f32x4 p0 = (f32x4){0.f, 0.f, 0.f, 0.f}, p1 = p0;
            if (!first) { const u32x4 pw = *(const u32x4*)mp; p0 = (f32x4){bf_lo(pw.x), bf_hi(pw.x), bf_lo(pw.y), bf_hi(pw.y)}; p1 = (f32x4){bf_lo(pw.z), bf_hi(pw.z), bf_lo(pw.w), bf_hi(pw.w)}; }
            v0[0] = p0[0] + v0[0] * bf_lo(gw.x); v0[1] = p0[1] + v0[1] * bf_hi(gw.x); v0[2] = p0[2] + v0[2] * bf_lo(gw.y); v0[3] = p0[3] + v0[3] * bf_hi(gw.y);
            v1[0] = p1[0] + v1[0] * bf_lo(gw.z); v1[1] = p1[1] + v1[1] * bf_hi(gw.z); v1[2] = p1[2] + v1[2] * bf_lo(gw.w); v1[3] = p1[3] + v1[3] * bf_hi(gw.w);
            *(u32x4*)mp = pack8(v0, v1);
        EPI_END
    }
};
struct EpiOut {
    static constexpr bool PERM = true;
    const float* xp; const float* xs; float* out; float* ssq;
    __device__ __forceinline__ void operator()(const f32x4 (&acc)[2][2][4][2], const Unit& u, int wr, int wc, int fr, int fq) const {
#pragma unroll
        for (int ai = 0; ai < 2; ++ai)
#pragma unroll
            for (int m = 0; m < 4; ++m) { const int row = u.pm * BM + ai * HALF + wr * 64 + m * 16 + fr;
                const float* xr = row < TP ? xp + (size_t)row * DM : xs + (size_t)(row - TP) * DM; float* orow = out + (size_t)row * DM; float sq = 0.f;
#pragma unroll
                for (int bj = 0; bj < 2; ++bj) { const int c = u.pn * 256 + bj * HALF + wc * 32 + 8 * fq;
                    f32x4 v0 = acc[ai][bj][m][0] * PROBE_BETA + *(const f32x4*)(xr + c), v1 = acc[ai][bj][m][1] * PROBE_BETA + *(const f32x4*)(xr + c + 4);
                    sq += (v0[0] * v0[0] + v0[1] * v0[1]) + (v0[2] * v0[2] + v0[3] * v0[3]) + (v1[0] * v1[0] + v1[1] * v1[1]) + (v1[2] * v1[2] + v1[3] * v1[3]);
                    *(f32x4*)(orow + c) = v0; *(f32x4*)(orow + c + 4) = v1; }
                sq += __shfl_xor(sq, 16); sq += __shfl_xor(sq, 32);
                if (fq == 0) ssq[(size_t)row * 32 + u.pn * 4 + wc] = sq; }
    }
};
}

#ifndef ATT_SDX
#define ATT_SDX 1
#endif
#ifndef QKT_SBAR
#define QKT_SBAR SBAR()
#endif
namespace att {
constexpr int QBLK = 32, KVBLK = 64, NW = 8;
constexpr float THR = 8.f;
constexpr int SHM_V = KVBLK * 128 * 2, SHM_K = KVBLK * 128 * 2, SHM_KX = KVBLK * 144;
constexpr int OFF_V = 0, OFF_K = 2 * SHM_V, OFF_KX = OFF_K + 2 * SHM_K, OFF_WS = OFF_KX + 2 * SHM_KX, OFF_QX = OFF_WS + NW * 64 * 4, SHM_ATTN = OFF_QX + NW * 4 * 64 * 16;
static_assert(SHM_ATTN <= 131072, "attention LDS");
#define KSWZ(row, colB) ((row) * 256 + ((colB) ^ (((row) & 7) << 4)))
#define KXSWZ(row, cbi) ((row) * 144 + ((cbi) << 4))
#define SBAR() __builtin_amdgcn_sched_barrier(0)
__device__ __forceinline__ int crow(int r, int hi) { return (r & 3) + 8 * (r >> 2) + 4 * hi; }

template <int SC> __device__ __forceinline__ void partialSM(f32x16& p0, f32x16& p1, float& m_reg, float& mn, float& alpha) {
  constexpr float SCALE = SC == 192 ? 0.07216878364870323f : 0.08838834764831843f;
  constexpr float C = SCALE * 1.4426950408889634f;
  float pmax = p0[0];
#pragma unroll
  for (int r = 1; r < 16; ++r) pmax = fmaxf(pmax, p0[r]);
#pragma unroll
  for (int r = 0; r < 16; ++r) pmax = fmaxf(pmax, p1[r]);
  { auto rr = __builtin_amdgcn_permlane32_swap(__float_as_uint(pmax), __float_as_uint(pmax), false, false);
    pmax = fmaxf(__uint_as_float(rr[0]), __uint_as_float(rr[1])); }
  if (__builtin_expect(__all(pmax - m_reg <= THR / SCALE), 1)) { mn = m_reg; alpha = 1.f; }
  else { mn = fmaxf(m_reg, pmax); alpha = __builtin_amdgcn_exp2f((m_reg - mn) * C); m_reg = mn; }
  float mnC = -mn * C;
#pragma unroll
  for (int r = 0; r < 16; ++r) p0[r] = fmaf(p0[r], C, mnC);
#pragma unroll
  for (int r = 0; r < 16; ++r) p1[r] = fmaf(p1[r], C, mnC);
#pragma unroll
  for (int r = 0; r < 16; ++r) p0[r] = __builtin_amdgcn_exp2f(p0[r]);
}
__device__ __forceinline__ void finishSM(f32x16& p0, f32x16& p1, float alpha, float& l_reg, bf16x8& pa0, bf16x8& pa1, bf16x8& pa2, bf16x8& pa3) {
#pragma unroll
  for (int r = 0; r < 16; ++r) p1[r] = __builtin_amdgcn_exp2f(p1[r]);
  float ps = 0;
#pragma unroll
  for (int r = 0; r < 16; ++r) ps += p0[r];
#pragma unroll
  for (int r = 0; r < 16; ++r) ps += p1[r];
  { auto rr = __builtin_amdgcn_permlane32_swap(__float_as_uint(ps), __float_as_uint(ps), false, false);
    ps = __uint_as_float(rr[0]) + __uint_as_float(rr[1]); }
  l_reg = l_reg * alpha + ps;
  SBAR();
#define PK4(P, BASE, OUT) do { unsigned a0 = cvt_pk_bf16(P[BASE + 0], P[BASE + 1]), a1 = cvt_pk_bf16(P[BASE + 2], P[BASE + 3]);   \
    unsigned b0 = cvt_pk_bf16(P[BASE + 4], P[BASE + 5]), b1 = cvt_pk_bf16(P[BASE + 6], P[BASE + 7]);                              \
    auto r0 = __builtin_amdgcn_permlane32_swap(a0, b0, false, false); auto r1 = __builtin_amdgcn_permlane32_swap(a1, b1, false, false); \
    u32x4 w = {r0[0], r1[0], r0[1], r1[1]}; OUT = *reinterpret_cast<bf16x8*>(&w); } while (0)
  PK4(p0, 0, pa0); PK4(p0, 8, pa1); PK4(p1, 0, pa2); PK4(p1, 8, pa3);
#undef PK4
}
template <int DKX> __device__ __forceinline__ void qkt(f32x16& p0, f32x16& p1, const LAS char* Ks, const LAS char* Kxs, const bf16x8* qr, const LAS char* qx, int r32, int hi) {
  p0 = f32x16{}; p1 = f32x16{};
#pragma unroll
  for (int d0 = 0; d0 < 8; ++d0) { int cb = (d0 * 16 + hi * 8) * 2;
    bf16x8 b0 = *(const LAS bf16x8*)(Ks + KSWZ(r32, cb));
    bf16x8 b1 = *(const LAS bf16x8*)(Ks + KSWZ(32 + r32, cb));
    p0 = __builtin_amdgcn_mfma_f32_32x32x16_bf16(b0, qr[d0], p0, 0, 0, 0);
    p1 = __builtin_amdgcn_mfma_f32_32x32x16_bf16(b1, qr[d0], p1, 0, 0, 0); }
  if constexpr (DKX > 0) {
    int zz = 0; asm volatile("" : "+v"(zz)); qx += zz;
    const LAS char* kxp = Kxs + KXSWZ(r32, hi);
#pragma unroll
    for (int dx = 0; dx < DKX / 16; ++dx) {
      bf16x8 b0 = *(const LAS bf16x8*)(kxp + dx * 32);
      bf16x8 b1 = *(const LAS bf16x8*)(kxp + dx * 32 + 32 * 144);
      const bf16x8 qf = *(const LAS bf16x8*)(qx + dx * 1024);
      p0 = __builtin_amdgcn_mfma_f32_32x32x16_bf16(b0, qf, p0, 0, 0, 0);
      p1 = __builtin_amdgcn_mfma_f32_32x32x16_bf16(b1, qf, p1, 0, 0, 0); }
  }
}
__device__ __forceinline__ int v_st(int k, int c) { const int kk = (k & ~0xC) | ((k & 4) << 1) | ((k & 8) >> 1); return ((kk >> 3) * 4 + (c >> 5)) * 512 + ((kk & 7) * 32 + (c & 31)) * 2; }
__device__ __forceinline__ int v_rd_base(int lane) { return ((lane & 3) << 3) | (((lane >> 2) & 3) << 6) | (((lane >> 4) & 1) << 5) | (((lane >> 5) & 1) << 8); }
constexpr int v_rd_off(int d0, int ks, int half) { return d0 * 512 + ks * 4096 + half * 2048; }
template <int OFF> __device__ __forceinline__ s16x4 tr_read(int vb) {
  s16x4 r; asm volatile("ds_read_b64_tr_b16 %0, %1 offset:%2" : "=&v"(r) : "v"(vb), "i"(OFF) : "memory"); return r;
}
template <int D0> __device__ __forceinline__ void pv_one(f32x16& od, int vb, bf16x8 pa0, bf16x8 pa1, bf16x8 pa2, bf16x8 pa3) {
  const s16x4 l0 = tr_read<v_rd_off(D0, 0, 0)>(vb), h0 = tr_read<v_rd_off(D0, 0, 1)>(vb), l1 = tr_read<v_rd_off(D0, 1, 0)>(vb), h1 = tr_read<v_rd_off(D0, 1, 1)>(vb);
  const s16x4 l2 = tr_read<v_rd_off(D0, 2, 0)>(vb), h2 = tr_read<v_rd_off(D0, 2, 1)>(vb), l3 = tr_read<v_rd_off(D0, 3, 0)>(vb), h3 = tr_read<v_rd_off(D0, 3, 1)>(vb);
  asm volatile("s_waitcnt lgkmcnt(0)" ::: "memory"); SBAR();
#define PK(L, H) (bf16x8){L[0], L[1], L[2], L[3], H[0], H[1], H[2], H[3]}
  od = __builtin_amdgcn_mfma_f32_32x32x16_bf16(pa0, PK(l0, h0), od, 0, 0, 0);
  od = __builtin_amdgcn_mfma_f32_32x32x16_bf16(pa1, PK(l1, h1), od, 0, 0, 0);
  od = __builtin_amdgcn_mfma_f32_32x32x16_bf16(pa2, PK(l2, h2), od, 0, 0, 0);
  od = __builtin_amdgcn_mfma_f32_32x32x16_bf16(pa3, PK(l3, h3), od, 0, 0, 0);
#undef PK
}
__device__ __forceinline__ void pv_d0(f32x16* o, int vb, bf16x8 pa0, bf16x8 pa1, bf16x8 pa2, bf16x8 pa3) {
  pv_one<0>(o[0], vb, pa0, pa1, pa2, pa3); pv_one<1>(o[1], vb, pa0, pa1, pa2, pa3); pv_one<2>(o[2], vb, pa0, pa1, pa2, pa3); pv_one<3>(o[3], vb, pa0, pa1, pa2, pa3);
}

template <int DKX, int LDQ, int LDK, int LDV, int SC>
__device__ __forceinline__ void attn_unit(const bf16_t* __restrict__ Qb, const bf16_t* __restrict__ Kh, const bf16_t* __restrict__ Kx, const bf16_t* __restrict__ Vh,
                                          bf16_t* Zb, int seq, LAS char* lds) {
  constexpr int SDEPTH = (DKX > 0) ? ATT_SDX : 2; constexpr int NQ = 8; constexpr int LDO = 3072;
  int tid = threadIdx.x; asm volatile("" : "+v"(tid));
  const int wid = tid >> 6, lane = tid & 63, r32 = lane & 31, hi = lane >> 5;
  LAS char* V_lds = lds + OFF_V; LAS char* K_lds = lds + OFF_K; LAS char* KX_lds = lds + OFF_KX;
  LAS float* ws = (LAS float*)(lds + OFF_WS) + wid * 64; LAS float* li_l = ws; LAS float* al_l = ws + 32;
  float m_reg = -1e30f, l_reg = 0; f32x16 o[4] = {}; bf16x8 qr[NQ];
  const bf16_t* Qw = Qb + (long)(wid * QBLK + r32) * LDQ + hi * 8;
#pragma unroll
  for (int d0 = 0; d0 < NQ; ++d0) qr[d0] = *reinterpret_cast<const bf16x8*>(Qw + d0 * 16);
  LAS char* qx = lds + OFF_QX + (wid * 256 + lane) * 16;
  if constexpr (DKX > 0) {
#pragma unroll
    for (int dx = 0; dx < DKX / 16; ++dx) *(LAS bf16x8*)(qx + dx * 1024) = *reinterpret_cast<const bf16x8*>(Qw + 128 + dx * 16);
  }
  const int sr = tid >> 4, sc = (tid & 15) * 8, vst0 = v_st(sr, sc), vst1 = v_st(32 + sr, sc);
  const int xr = tid >> 3, xc = tid & 7, kxst = KXSWZ(xr, xc);
  const int vb0 = (int)(unsigned)(uintptr_t)V_lds + v_rd_base(lane);
  const unsigned vof0 = (unsigned)(sr * LDV + sc), vof1 = vof0 + 32u * LDV, kof0 = (unsigned)(sr * LDK + sc), kof1 = kof0 + 32u * LDK, xof = (unsigned)(xr * 64 + xc * 8);
  struct { bf16x8 vs0, vs1, ks0, ks1, kx; } sr_[SDEPTH];
#define SLOAD(i, k0) do { const bf16_t* Vt_ = Vh + (size_t)(k0) * LDV; const bf16_t* Kt_ = Kh + (size_t)(k0) * LDK; \
    sr_[i].vs0 = *reinterpret_cast<const bf16x8*>(Vt_ + vof0); sr_[i].vs1 = *reinterpret_cast<const bf16x8*>(Vt_ + vof1); \
    sr_[i].ks0 = *reinterpret_cast<const bf16x8*>(Kt_ + kof0); sr_[i].ks1 = *reinterpret_cast<const bf16x8*>(Kt_ + kof1); \
    if constexpr (DKX > 0) { const bf16_t* Xt_ = Kx + (size_t)(k0) * 64; sr_[i].kx = *reinterpret_cast<const bf16x8*>(Xt_ + xof); } } while (0)
#define SWRITE(b, i) do { *(LAS bf16x8*)(V_lds + (b) * SHM_V + vst0) = sr_[i].vs0;          \
    *(LAS bf16x8*)(V_lds + (b) * SHM_V + vst1) = sr_[i].vs1; int kc = sc * 2;               \
    *(LAS bf16x8*)(K_lds + (b) * SHM_K + KSWZ(sr, kc)) = sr_[i].ks0;                       \
    *(LAS bf16x8*)(K_lds + (b) * SHM_K + KSWZ(32 + sr, kc)) = sr_[i].ks1;                   \
    if constexpr (DKX > 0) *(LAS bf16x8*)(KX_lds + (b) * SHM_KX + kxst) = sr_[i].kx; } while (0)
#define SWAIT() do { if constexpr (SDEPTH == 1) asm volatile("s_waitcnt vmcnt(0)" ::: "memory"); else if constexpr (DKX > 0) asm volatile("s_waitcnt vmcnt(5)" ::: "memory"); else asm volatile("s_waitcnt vmcnt(4)" ::: "memory"); } while (0)
#define RESC(a) do { if (__any((a) < 1.f)) { if (hi == 0) al_l[r32] = (a); asm volatile("s_waitcnt lgkmcnt(0)" ::: "memory"); \
    _Pragma("unroll") for (int d = 0; d < 4; ++d) _Pragma("unroll") for (int r = 0; r < 16; ++r) o[d][r] *= al_l[crow(r, hi)]; } } while (0)
  f32x16 pA0, pA1, pB0, pB1; float mnA, mnB, alA, alB; bf16x8 pa0, pa1, pa2, pa3; const int NT = seq / KVBLK;
  constexpr int SE = 0, SO = SDEPTH - 1;
  SLOAD(SE, 0); asm volatile("s_waitcnt vmcnt(0)" ::: "memory"); SWRITE(0, SE); __syncthreads();
  qkt<DKX>(pA0, pA1, K_lds, KX_lds, qr, qx, r32, hi); partialSM<SC>(pA0, pA1, m_reg, mnA, alA);
  SLOAD(SO, KVBLK); if constexpr (SDEPTH == 2) { if (2 < NT) SLOAD(SE, 2 * KVBLK); }
  SWAIT(); SWRITE(1, SO); __syncthreads();
  for (int j = 1; j + 1 < NT; j += 2) {
    SBAR(); qkt<DKX>(pB0, pB1, K_lds + SHM_K, KX_lds + SHM_KX, qr, qx, r32, hi);
    finishSM(pA0, pA1, alA, l_reg, pa0, pa1, pa2, pa3); SBAR();
    SLOAD(SO, (j + SDEPTH) * KVBLK); SBAR();
    pv_d0(o, vb0, pa0, pa1, pa2, pa3); partialSM<SC>(pB0, pB1, m_reg, mnB, alB);
    __syncthreads(); SWAIT(); SWRITE(0, SE);
    RESC(alB); __syncthreads();
    SBAR(); qkt<DKX>(pA0, pA1, K_lds, KX_lds, qr, qx, r32, hi);
    finishSM(pB0, pB1, alB, l_reg, pa0, pa1, pa2, pa3); SBAR();
    if (SDEPTH == 1 || j + 3 < NT) SLOAD(SE, (j + 1 + SDEPTH) * KVBLK); SBAR();
    pv_d0(o, vb0 + (int)SHM_V, pa0, pa1, pa2, pa3); partialSM<SC>(pA0, pA1, m_reg, mnA, alA);
    __syncthreads(); SWAIT(); SWRITE(1, SO);
    RESC(alA); __syncthreads();
  }
  SBAR(); qkt<DKX>(pB0, pB1, K_lds + SHM_K, KX_lds + SHM_KX, qr, qx, r32, hi);
  finishSM(pA0, pA1, alA, l_reg, pa0, pa1, pa2, pa3); SBAR();
  pv_d0(o, vb0, pa0, pa1, pa2, pa3); partialSM<SC>(pB0, pB1, m_reg, mnB, alB);
  __syncthreads(); RESC(alB);
  finishSM(pB0, pB1, alB, l_reg, pa0, pa1, pa2, pa3); SBAR();
  pv_d0(o, vb0 + (int)SHM_V, pa0, pa1, pa2, pa3);
  if (hi == 0) li_l[r32] = l_reg; asm volatile("s_waitcnt lgkmcnt(0)" ::: "memory");
#pragma unroll
  for (int r = 0; r < 16; ++r) { const float rl_ = __builtin_amdgcn_rcpf(li_l[crow(r, hi)]);
#pragma unroll
    for (int d0 = 0; d0 < 4; ++d0) o[d0][r] *= rl_; }
  bf16_t* Zw = Zb + (long)(wid * QBLK) * LDO + r32;
#pragma unroll
  for (int d0 = 0; d0 < 4; ++d0)
#pragma unroll
    for (int rh = 0; rh < 2; ++rh) { bf16_t zv[8];
#pragma unroll
      for (int r = 0; r < 8; ++r) zv[r] = Zw[(long)crow(rh * 8 + r, hi) * LDO + d0 * 32];
#pragma unroll
      for (int r = 0; r < 8; ++r) Zw[(long)crow(rh * 8 + r, hi) * LDO + d0 * 32] = (bf16_t)(cvt_pk_bf16(o[d0][rh * 8 + r] * __uint_as_float((unsigned)zv[r] << 16), 0.f) & 0xffffu); }
#undef SLOAD
#undef SWRITE
#undef SWAIT
#undef RESC
}
}

__device__ __forceinline__ void mem_attn_wave(const bf16_t* __restrict__ QM, const bf16_t* __restrict__ KM, const bf16_t* __restrict__ VMT, bf16_t* Z, int b, int h, int rg, int lane) {
    const int jr = lane & 15, q = lane >> 4;
    const size_t row = (size_t)b * SEQ + rg * 16 + jr;
    bf16x8 qf[8];
#pragma unroll
    for (int c = 0; c < 8; ++c) qf[c] = *(const bf16x8*)(QM + row * 1024 + h * 256 + 32 * c + 8 * q);
    f32x4 S[16];
    const bf16_t* kb = KM + ((size_t)b * 256 + jr) * 1024 + h * 256 + 8 * q;
#pragma unroll
    for (int n = 0; n < 16; ++n) { f32x4 acc = (f32x4){0.f, 0.f, 0.f, 0.f};
#pragma unroll
        for (int c = 0; c < 8; ++c) { const bf16x8 kf = *(const bf16x8*)(kb + (size_t)n * 16 * 1024 + 32 * c); acc = __builtin_amdgcn_mfma_f32_16x16x32_bf16(kf, qf[c], acc, 0, 0, 0); }
        S[n] = acc; }
    float m = -1e30f;
#pragma unroll
    for (int n = 0; n < 16; ++n) m = fmaxf(fmaxf(fmaxf(S[n][0], S[n][1]), fmaxf(S[n][2], S[n][3])), m);
    m = fmaxf(m, __shfl_xor(m, 16)); m = fmaxf(m, __shfl_xor(m, 32));
    constexpr float C = 0.0625f * 1.4426950408889634f; const float mC = -m * C; float l = 0.f;
#pragma unroll
    for (int n = 0; n < 16; ++n)
#pragma unroll
        for (int e = 0; e < 4; ++e) { const float p = __builtin_amdgcn_exp2f(fmaf(S[n][e], C, mC)); S[n][e] = p; l += p; }
    l += __shfl_xor(l, 16); l += __shfl_xor(l, 32);
    const float rl = __builtin_amdgcn_rcpf(l);
    __builtin_amdgcn_sched_barrier(0);
    bf16x8 pf[8];
#pragma unroll
    for (int c = 0; c < 8; ++c) { u32x4 w; w.x = cvt_pk_bf16(S[2 * c][0], S[2 * c][1]); w.y = cvt_pk_bf16(S[2 * c][2], S[2 * c][3]); w.z = cvt_pk_bf16(S[2 * c + 1][0], S[2 * c + 1][1]); w.w = cvt_pk_bf16(S[2 * c + 1][2], S[2 * c + 1][3]);
        pf[c] = *reinterpret_cast<bf16x8*>(&w); }
    const bf16_t* vb = VMT + ((size_t)h * 256 + jr) * MEMROWS + b * 256 + 8 * q;
    bf16_t* zrow = Z + row * 3072 + 2048 + h * 256 + 4 * q;
    u32x2 zz[16];
#pragma unroll
    for (int n = 0; n < 16; ++n) zz[n] = *(const u32x2*)(zrow + 16 * n);
#pragma unroll
    for (int n = 0; n < 16; ++n) { f32x4 acc = (f32x4){0.f, 0.f, 0.f, 0.f};
#pragma unroll
        for (int c = 0; c < 8; ++c) { const bf16x8 vf = *(const bf16x8*)(vb + (size_t)n * 16 * MEMROWS + 32 * c); acc = __builtin_amdgcn_mfma_f32_16x16x32_bf16(vf, pf[c], acc, 0, 0, 0); }
        u32x2 w; w.x = cvt_pk_bf16(acc[0] * rl * bf_lo(zz[n].x), acc[1] * rl * bf_hi(zz[n].x)); w.y = cvt_pk_bf16(acc[2] * rl * bf_lo(zz[n].y), acc[3] * rl * bf_hi(zz[n].y));
        *(u32x2*)(zrow + 16 * n) = w; }
}


__device__ __forceinline__ void mem_attn_block(const bf16_t* __restrict__ QM, const bf16_t* __restrict__ KM, const bf16_t* __restrict__ VMT, bf16_t* Z, int b, int h, int rb, LAS unsigned char* lds, int tid_in) {
    int tid = tid_in; asm volatile("" : "+v"(tid));
    const int wave = tid >> 6, lane = tid & 63, jr = lane & 15, q = lane >> 4;
    const size_t row = (size_t)b * SEQ + rb * 128 + wave * 16 + jr;
    {
        u32x4 st[16];
#pragma unroll
        for (int i = 0; i < 16; ++i) { const int g = tid + 512 * i, r_ = g >> 5, ch = g & 31; st[i] = *(const u32x4*)(KM + ((size_t)b * 256 + r_) * 1024 + h * 256 + ch * 8); }
#pragma unroll
        for (int i = 0; i < 16; ++i) { const int g = tid + 512 * i, r_ = g >> 5, ch = g & 31; *(LAS u32x4*)(lds + r_ * 512 + ((ch ^ (r_ & 15)) << 4)) = st[i]; }
    }
    bf16x8 qf[8];
#pragma unroll
    for (int c = 0; c < 8; ++c) qf[c] = *(const bf16x8*)(QM + row * 1024 + h * 256 + 32 * c + 8 * q);
    __syncthreads();
    f32x4 S[16];
#pragma unroll
    for (int n = 0; n < 16; ++n) { f32x4 acc = (f32x4){0.f, 0.f, 0.f, 0.f};
#pragma unroll
        for (int c = 0; c < 8; ++c) { const bf16x8 kf = *(const LAS bf16x8*)(lds + (16 * n + jr) * 512 + (((4 * c + q) ^ jr) << 4)); acc = __builtin_amdgcn_mfma_f32_16x16x32_bf16(kf, qf[c], acc, 0, 0, 0); }
        S[n] = acc; __builtin_amdgcn_sched_barrier(0); }
    float m = -1e30f;
#pragma unroll
    for (int n = 0; n < 16; ++n) m = fmaxf(fmaxf(fmaxf(S[n][0], S[n][1]), fmaxf(S[n][2], S[n][3])), m);
    m = fmaxf(m, __shfl_xor(m, 16)); m = fmaxf(m, __shfl_xor(m, 32));
    constexpr float C = 0.0625f * 1.4426950408889634f; const float mC = -m * C; float l = 0.f;
#pragma unroll
    for (int n = 0; n < 16; ++n)
#pragma unroll
        for (int e = 0; e < 4; ++e) { const float p = __builtin_amdgcn_exp2f(fmaf(S[n][e], C, mC)); S[n][e] = p; l += p; }
    l += __shfl_xor(l, 16); l += __shfl_xor(l, 32);
    const float rl = __builtin_amdgcn_rcpf(l);
    __builtin_amdgcn_sched_barrier(0);
    bf16x8 pf[8];
#pragma unroll
    for (int c = 0; c < 8; ++c) { u32x4 w; w.x = cvt_pk_bf16(S[2 * c][0], S[2 * c][1]); w.y = cvt_pk_bf16(S[2 * c][2], S[2 * c][3]); w.z = cvt_pk_bf16(S[2 * c + 1][0], S[2 * c + 1][1]); w.w = cvt_pk_bf16(S[2 * c + 1][2], S[2 * c + 1][3]);
        pf[c] = *reinterpret_cast<bf16x8*>(&w); }
    bf16_t* zrow = Z + row * 3072 + 2048 + h * 256 + 4 * q;
    u32x2 zz[16];
#pragma unroll
    for (int n = 0; n < 16; ++n) zz[n] = *(const u32x2*)(zrow + 16 * n);
    __syncthreads();
    {
        u32x4 st[16];
#pragma unroll
        for (int i = 0; i < 16; ++i) { const int g = tid + 512 * i, r_ = g >> 5, ch = g & 31; st[i] = *(const u32x4*)(VMT + ((size_t)h * 256 + r_) * MEMROWS + b * 256 + ch * 8); }
#pragma unroll
        for (int i = 0; i < 16; ++i) { const int g = tid + 512 * i, r_ = g >> 5, ch = g & 31; *(LAS u32x4*)(lds + r_ * 512 + ((ch ^ (r_ & 15)) << 4)) = st[i]; }
    }
    __syncthreads();
#pragma unroll
    for (int n = 0; n < 16; ++n) { f32x4 acc = (f32x4){0.f, 0.f, 0.f, 0.f};
#pragma unroll
        for (int c = 0; c < 8; ++c) { const bf16x8 vf = *(const LAS bf16x8*)(lds + (16 * n + jr) * 512 + (((4 * c + q) ^ jr) << 4)); acc = __builtin_amdgcn_mfma_f32_16x16x32_bf16(vf, pf[c], acc, 0, 0, 0); }
        u32x2 w; w.x = cvt_pk_bf16(acc[0] * rl * bf_lo(zz[n].x), acc[1] * rl * bf_hi(zz[n].x)); w.y = cvt_pk_bf16(acc[2] * rl * bf_lo(zz[n].y), acc[3] * rl * bf_hi(zz[n].y));
        *(u32x2*)(zrow + 16 * n) = w; __builtin_amdgcn_sched_barrier(0); }
    __syncthreads();
}

__device__ __forceinline__ int gperm_inv128(int p) { const int a = p >> 6, t = p & 63; return 64 * a + 32 * (t & 1) + (t >> 1); }
__device__ __forceinline__ int gperm_inv64(int p) { const int a = p >> 5, t = p & 31; return 32 * a + 16 * (t & 1) + (t >> 1); }
__device__ __forceinline__ int colmap(int kind, int n) {
    if (kind == 0) {
        if (n < 768) return n;
        if (n < 1024) { const int j = n - 768; return j < 64 ? 768 + gperm_inv64(j) : -1; }
        if (n < 2048) { const int j = n - 1024; return 832 + (j & ~127) + gperm_inv128(j & 127); }
        if (n < 2304) { const int j = n - 2048; return 1856 + (j & ~127) + gperm_inv128(j & 127); }
        return n - 2304 + 2112;
    }
    if (kind == 1) return 6464 + n;
    if (kind == 2) { const int h = n / 192, d = n % 192; return h * 192 + (d < 128 ? d : 128 + gperm_inv64(d - 128)); }
    if (kind == 3) { if (n < 1024) return (n >> 7) * 256 + (n & 127); const int m = n - 1024; return (m >> 7) * 256 + 128 + (m & 127); }
    return n;
}
__device__ __forceinline__ void transpose_item(const float* __restrict__ W, int ldw, int K, bf16_t* WT, int kind, int item, LAS unsigned char* scr, int tid) {
    const int nkb = K >> 6; const int nb = item / nkb, kb = item - nb * nkb; const int n0 = nb * 64, k0 = kb * 64;
    const int nl = tid & 63, kg = tid >> 6;
    const int col = colmap(kind, n0 + nl);
    float v[8];
#pragma unroll
    for (int j = 0; j < 8; ++j) v[j] = col >= 0 ? W[(size_t)(k0 + 8 * kg + j) * ldw + col] : 0.f;
    u32x4 o; o.x = cvt_pk_bf16(v[0], v[1]); o.y = cvt_pk_bf16(v[2], v[3]); o.z = cvt_pk_bf16(v[4], v[5]); o.w = cvt_pk_bf16(v[6], v[7]);
    *(LAS u32x4*)(scr + nl * 144 + kg * 16) = o;
    __syncthreads();
    const int row = tid >> 3, ch = tid & 7;
    const u32x4 w = *(const LAS u32x4*)(scr + row * 144 + ch * 16);
    *(u32x4*)(WT + (size_t)(n0 + row) * K + k0 + 8 * ch) = w;
    __syncthreads();
}

__device__ __forceinline__ unsigned pk4_fp8(float a, float b, float c, float d) { int w = __builtin_amdgcn_cvt_pk_fp8_f32(a, b, 0, false); w = __builtin_amdgcn_cvt_pk_fp8_f32(c, d, w, true); return (unsigned)w; }
__device__ __forceinline__ void transpose_item_fp8(const float* __restrict__ W, int ldw, int K, unsigned char* WT, int col0, int item, LAS unsigned char* scr, int tid) {
    const int nkb = K >> 6; const int nb = item / nkb, kb = item - nb * nkb; const int n0 = nb * 64, k0 = kb * 64;
    const int nl = tid & 63, kg = tid >> 6;
    float v[8];
#pragma unroll
    for (int j = 0; j < 8; ++j) v[j] = W8_SCALE * W[(size_t)(k0 + 8 * kg + j) * ldw + col0 + n0 + nl];
    u32x2 o; o.x = pk4_fp8(v[0], v[1], v[2], v[3]); o.y = pk4_fp8(v[4], v[5], v[6], v[7]);
    *(LAS u32x2*)(scr + nl * 72 + kg * 8) = o;
    __syncthreads();
    const int row = tid >> 3, ch = tid & 7;
    const u32x2 w = *(const LAS u32x2*)(scr + row * 72 + ch * 8);
    *(u32x2*)(WT + (size_t)(n0 + row) * K + k0 + 8 * ch) = w;
    __syncthreads();
}
__device__ __forceinline__ void rms_row_to_bf16(const float* __restrict__ xrow, const float* __restrict__ g, bf16_t* orow, unsigned char* o8row, int lane) {
    f32x4 v[8]; float s = 0.f;
#pragma unroll
    for (int j = 0; j < 8; ++j) { v[j] = ((const f32x4*)xrow)[lane + 64 * j]; s += (v[j][0] * v[j][0] + v[j][1] * v[j][1]) + (v[j][2] * v[j][2] + v[j][3] * v[j][3]); }
    const float rstd = 1.0f / sqrtf(wave_sum(s) * (1.f / DM) + EPS);
#pragma unroll
    for (int j = 0; j < 8; ++j) { const f32x4 gg = ((const f32x4*)g)[lane + 64 * j]; u32x2 w; w.x = cvt_pk_bf16(v[j][0] * rstd * gg[0], v[j][1] * rstd * gg[1]); w.y = cvt_pk_bf16(v[j][2] * rstd * gg[2], v[j][3] * rstd * gg[3]);
        ((u32x2*)orow)[lane + 64 * j] = w;
        if (o8row) ((unsigned*)o8row)[lane + 64 * j] = pk4_fp8(H8_SCALE * v[j][0] * rstd * gg[0], H8_SCALE * v[j][1] * rstd * gg[1], H8_SCALE * v[j][2] * rstd * gg[2], H8_SCALE * v[j][3] * rstd * gg[3]); }
}
__device__ __forceinline__ void sincos_d(float angf, float& c, float& s) {
    const double a = (double)angf; const double kq = rint(a * 0.63661977236758134308); const double r = a - kq * 1.57079632679489661923; const int qd = ((int)kq) & 3;
    const double r2 = r * r;
    const double sp = r * (1.0 + r2 * (-1.0 / 6 + r2 * (1.0 / 120 + r2 * (-1.0 / 5040 + r2 * (1.0 / 362880 + r2 * (-1.0 / 39916800 + r2 * (1.0 / 6227020800.0)))))));
    const double cp = 1.0 + r2 * (-0.5 + r2 * (1.0 / 24 + r2 * (-1.0 / 720 + r2 * (1.0 / 40320 + r2 * (-1.0 / 3628800 + r2 * (1.0 / 479001600 + r2 * (-1.0 / 87178291200.0)))))));
    double sv, cv;
    if (qd == 0) { sv = sp; cv = cp; } else if (qd == 1) { sv = cp; cv = -sp; } else if (qd == 2) { sv = -sp; cv = -cp; } else { sv = -cp; cv = sp; }
    c = (float)cv; s = (float)sv;
}

__device__ __forceinline__ void grid_barrier(unsigned* ctr, unsigned target) {
    __syncthreads();
    if (threadIdx.x == 0) {
        __builtin_amdgcn_fence(__ATOMIC_RELEASE, "agent");
        __hip_atomic_fetch_add(ctr, 1u, __ATOMIC_RELAXED, __HIP_MEMORY_SCOPE_AGENT);
        while (__hip_atomic_load(ctr, __ATOMIC_RELAXED, __HIP_MEMORY_SCOPE_AGENT) < target) __builtin_amdgcn_s_sleep(4);
    }
    __syncthreads();
    __builtin_amdgcn_fence(__ATOMIC_ACQUIRE, "agent");
}
struct Args { const float* in[17]; float* out; unsigned char* ws; int ph_lo, ph_hi; };
constexpr int NPHASE = 9;

template <bool COOP>
__global__ void __launch_bounds__(512) mk_fwd(Args args) {
    extern __shared__ __attribute__((aligned(16))) unsigned char lds_raw[];
    LAS unsigned char* lds = (LAS unsigned char*)lds_raw;
    const int tid = threadIdx.x, lane = tid & 63, wave = __builtin_amdgcn_readfirstlane(tid >> 6);
    const int G = gridDim.x, bid = blockIdx.x;
    const int gw = bid * 8 + wave, NGW = G * 8;
    unsigned char* ws = args.ws; unsigned char* dob = (unsigned char*)args.out;
    const float* xp = args.in[0]; const float* xs = args.in[1];
    bf16_t* H = (bf16_t*)(dob + DO_H); bf16_t* QMLA = (bf16_t*)(dob + DO_QMLA); bf16_t* MN = (bf16_t*)(dob + DO_MN);
    f32x2* TABG = (f32x2*)(ws + WS_TABG); f32x2* TABM = (f32x2*)(ws + WS_TABM); float* GQP = (float*)(ws + WS_GQP); float* GKP = (float*)(ws + WS_GKP);
    const int lo = args.ph_lo, hi = args.ph_hi;
    if constexpr (COOP) cg::this_grid().sync();
    __builtin_amdgcn_fence(__ATOMIC_ACQUIRE, "agent");
#ifndef ONLY
#define ONLY -1
#endif
#define IN(k) ((ONLY < 0 || ONLY == (k)) && lo <= (k) && (k) < hi)
    unsigned nbar = 0;
#define SEAM(k) do { if constexpr (COOP) { if (IN(k) && IN((k) + 1)) { ++nbar; grid_barrier((unsigned*)(ws + WS_BAR), nbar * (unsigned)G); } } } while (0)

    if (IN(0)) {
        constexpr int I0 = (NP1 / 64) * 32, I1 = 96 * 32, I2 = 24 * 8, I3 = 32 * 4, I4 = 32 * 32, I5 = 32 * 16, I6 = 32 * 32;
        constexpr int NITEMS = I0 + I1 + I2 + I3 + I4 + 3 * I5 + I6;
        for (int it = bid; it < NITEMS; it += G) {
            int r = it;
            if (r < I0) { transpose_item(args.in[5], 12608, 2048, (bf16_t*)(ws + WS_WIN), 0, r, lds, tid); continue; } r -= I0;
            if (r < I1) { transpose_item_fp8(args.in[5], 12608, 2048, ws + WS_WGL, 6464, r, lds, tid); continue; } r -= I1;
            if (r < I2) { transpose_item(args.in[7], 1536, 512, (bf16_t*)(ws + WS_WQB), 2, r, lds, tid); continue; } r -= I2;
            if (r < I3) { transpose_item(args.in[9], 2048, 256, (bf16_t*)(ws + WS_WKVB), 3, r, lds, tid); continue; } r -= I3;
            if (r < I4) { transpose_item(args.in[13], 2048, 2048, (bf16_t*)(ws + WS_WMKV), 4, r, lds, tid); continue; } r -= I4;
            if (r < 3 * I5) { const int i = r / I5; transpose_item(args.in[14] + (size_t)i * 1024 * 2048, 2048, 1024, (bf16_t*)(ws + WS_WBR) + (size_t)i * 2048 * 1024, 4, r - i * I5, lds, tid); continue; } r -= 3 * I5;
            transpose_item(args.in[15], 2048, 2048, (bf16_t*)(ws + WS_WOUT), 4, r, lds, tid);
        }
        for (int m = gw; m < T + MEMROWS; m += NGW) {
            if (m < T) { const float* xr = m < TP ? xp + (size_t)m * DM : xs + (size_t)(m - TP) * DM; rms_row_to_bf16(xr, args.in[4], H + (size_t)m * DM, ws + WS_H8 + (size_t)m * DM, lane); }
            else { const int mm = m - T; const float* xr = mm < 2048 ? args.in[2] + (size_t)mm * DM : args.in[3] + (size_t)(mm - 2048) * DM; rms_row_to_bf16(xr, args.in[12], MN + (size_t)mm * DM, nullptr, lane); }
        }
        for (int e = bid * 512 + tid; e < 4096 * 64 * 2 / 16; e += G * 512) ((u32x4*)(ws + WS_ZERO))[e] = (u32x4){0u, 0u, 0u, 0u};
        if (bid == 0) {
            for (int e = tid; e < 64 * 32; e += 512) { const int pos = e >> 5, i = e & 31; double f = 1.0; for (int k = 0; k < i; ++k) f *= 0.7498942093324559; const float ang = (float)pos * (float)f; float c, s; sincos_d(ang, c, s); TABG[e] = (f32x2){c, s}; }
            for (int e = tid; e < 64 * 16; e += 512) { const int pos = e >> 4, i = e & 15; double f = 1.0; for (int k = 0; k < i; ++k) f *= 0.5623413251903491; const float ang = (float)pos * (float)f; float c, s; sincos_d(ang, c, s); TABM[e] = (f32x2){c, s}; }
            if (tid < 128) { GQP[tid] = args.in[10][gperm_inv128(tid)]; GKP[tid] = args.in[11][gperm_inv128(tid)]; }
        }
    }
    SEAM(0);

    if (IN(1)) {
        { pg8::Gemm g{H, (const bf16_t*)(ws + WS_WIN), 2048, 2048, T, NP1, 2048}; pg8::StaticOrder S; S.init(T, NP1, G, bid);
          pg8::EpiP1 E{ws}; pg8::gemm_phase(lds, g, S, E); }
        { pg8::Gemm g{MN, (const bf16_t*)(ws + WS_WMKV), 2048, 2048, MEMROWS, 2048, 2048}; pg8::StaticOrder S; S.init(MEMROWS, 2048, G, (bid + 128) % G);
          pg8::EpiSplit E{(bf16_t*)(ws + WS_KM), (bf16_t*)(ws + WS_VM), 1024}; pg8::gemm_phase(lds, g, S, E); }
    }
    SEAM(1);

    if (IN(2)) {
        bf16_t* CQ = (bf16_t*)(ws + WS_CQ); bf16_t* CKV = (bf16_t*)(ws + WS_CKV); bf16_t* KPE = (bf16_t*)(ws + WS_KPE); bf16_t* QG = (bf16_t*)(ws + WS_QG); bf16_t* KG = (bf16_t*)(ws + WS_KG);
        const float* gq = args.in[6]; const float* gkv = args.in[8];
        const int ga_ = lane >> 5, gi_ = lane & 31; const float gq1 = GQP[2 * lane], gq2 = GQP[2 * lane + 1], gk1 = GKP[2 * lane], gk2 = GKP[2 * lane + 1];
        const f32x4 g0q = *(const f32x4*)(gq + lane * 8), g1q = *(const f32x4*)(gq + lane * 8 + 4), g0k = *(const f32x4*)(gkv + lane * 4);
        for (int r = gw; r < T; r += NGW) {
            const int s = r & 4095, prow = s >> 6, pcol = s & 63;
            bf16_t* pq = CQ + (size_t)r * 512 + lane * 8; bf16_t* pk = CKV + (size_t)r * 256 + lane * 4; unsigned* pe = (unsigned*)(KPE + (size_t)r * 64) + (lane & 31);
            const u32x4 wq = *(const u32x4*)pq; const u32x2 wk = *(const u32x2*)pk; const unsigned we = *pe;
            unsigned wh[10];
#pragma unroll
            for (int h = 0; h < 10; ++h) wh[h] = *((h < 8 ? (const unsigned*)(QG + (size_t)r * 1024 + h * 128) : (const unsigned*)(KG + (size_t)r * 256 + (h - 8) * 128)) + lane);
            const f32x2 csm = TABM[(((lane >> 4) & 1) ? pcol : prow) * 16 + (lane & 15)]; const f32x2 cs = TABG[(ga_ ? pcol : prow) * 32 + gi_];
            { float x[8] = {bf_lo(wq.x), bf_hi(wq.x), bf_lo(wq.y), bf_hi(wq.y), bf_lo(wq.z), bf_hi(wq.z), bf_lo(wq.w), bf_hi(wq.w)};
              float ss = 0.f;
#pragma unroll
              for (int j = 0; j < 8; ++j) ss += x[j] * x[j];
              const float rstd = 1.0f / sqrtf(wave_sum(ss) * (1.f / 512) + EPS);
              u32x4 o; o.x = cvt_pk_bf16(x[0] * rstd * g0q[0], x[1] * rstd * g0q[1]); o.y = cvt_pk_bf16(x[2] * rstd * g0q[2], x[3] * rstd * g0q[3]); o.z = cvt_pk_bf16(x[4] * rstd * g1q[0], x[5] * rstd * g1q[1]); o.w = cvt_pk_bf16(x[6] * rstd * g1q[2], x[7] * rstd * g1q[3]);
              *(u32x4*)pq = o; }
            { float x[4] = {bf_lo(wk.x), bf_hi(wk.x), bf_lo(wk.y), bf_hi(wk.y)};
              const float ss = (x[0] * x[0] + x[1] * x[1]) + (x[2] * x[2] + x[3] * x[3]);
              const float rstd = 1.0f / sqrtf(wave_sum(ss) * (1.f / 256) + EPS);
              u32x2 o; o.x = cvt_pk_bf16(x[0] * rstd * g0k[0], x[1] * rstd * g0k[1]); o.y = cvt_pk_bf16(x[2] * rstd * g0k[2], x[3] * rstd * g0k[3]); *(u32x2*)pk = o; }
            if (lane < 32) { const float x1 = bf_lo(we), x2 = bf_hi(we); *pe = cvt_pk_bf16(x1 * csm[0] - x2 * csm[1], x2 * csm[0] + x1 * csm[1]); }
#pragma unroll
            for (int h = 0; h < 10; ++h) { float x1 = bf_lo(wh[h]), x2 = bf_hi(wh[h]); const float rstd = 1.0f / sqrtf(wave_sum(x1 * x1 + x2 * x2) * (1.f / 128) + EPS);
                x1 = x1 * rstd * (h < 8 ? gq1 : gk1); x2 = x2 * rstd * (h < 8 ? gq2 : gk2);
                *((h < 8 ? (unsigned*)(QG + (size_t)r * 1024 + h * 128) : (unsigned*)(KG + (size_t)r * 256 + (h - 8) * 128)) + lane) = cvt_pk_bf16(x1 * cs[0] - x2 * cs[1], x2 * cs[0] + x1 * cs[1]); }
        }
        const bf16_t* VM = (const bf16_t*)(ws + WS_VM); bf16_t* VMT = (bf16_t*)(ws + WS_VMT);
        for (int ln = gw; ln < 1024 * NBATCH * 4; ln += NGW) { const int c = ln / (NBATCH * 4), rem = ln - c * (NBATCH * 4); const int b = rem >> 2, seg = rem & 3;
            const int pos = seg * 64 + lane; const int key = (pos & ~31) + 16 * ((pos >> 2) & 1) + 4 * ((pos >> 3) & 3) + (pos & 3);
            VMT[(size_t)c * MEMROWS + b * 256 + pos] = VM[(size_t)(b * 256 + key) * 1024 + c]; }
    }
    SEAM(2);


    if (IN(3)) {
        { pg8::Gemm g{(const bf16_t*)(ws + WS_CQ), (const bf16_t*)(ws + WS_WQB), 512, 512, T, 1536, 512}; pg8::StaticOrder S; S.init(T, 1536, G, bid);
          pg8::EpiQ E{QMLA, TABM}; pg8::gemm_phase(lds, g, S, E); }
        { pg8::Gemm g{(const bf16_t*)(ws + WS_CKV), (const bf16_t*)(ws + WS_WKVB), 256, 256, T, 2048, 256}; pg8::StaticOrder S; S.init(T, 2048, G, bid);
          pg8::EpiSplit E{(bf16_t*)(ws + WS_KN), (bf16_t*)(ws + WS_VN), 1024}; pg8::gemm_phase(lds, g, S, E); }
    }
    SEAM(3);


    if (IN(4)) {
        bf16_t* Z = (bf16_t*)(ws + WS_Z);
        const int NU = NBATCH * 8 * 16;
#define DECODE_UNIT(u) int bh, qb; if (G == 256) { const int i_ = (u) >> 8, c_ = (u) & 255; qb = (c_ >> 3) & 15; bh = i_ * 16 + (c_ & 7) * 2 + (c_ >> 7); } else { bh = (u) >> 4; qb = (u) & 15; } \
        const int b = bh >> 3, h = bh & 7; const size_t r0 = (size_t)b * SEQ + qb * 256;
#ifndef SKIP_MLA
        for (int u = bid; u < NU; u += G) { DECODE_UNIT(u)
            att::attn_unit<64, 1536, 1024, 1024, 192>(QMLA + r0 * 1536 + h * 192, (const bf16_t*)(ws + WS_KN) + (size_t)b * SEQ * 1024 + h * 128, (const bf16_t*)(ws + WS_KPE) + (size_t)b * SEQ * 64,
                                                  (const bf16_t*)(ws + WS_VN) + (size_t)b * SEQ * 1024 + h * 128, Z + r0 * 3072 + h * 128, SEQ, (LAS char*)lds); }
#endif
#ifndef SKIP_GQA
        for (int u = bid; u < NU; u += G) { DECODE_UNIT(u)
            att::attn_unit<0, 1024, 256, 256, 128>((const bf16_t*)(ws + WS_QG) + r0 * 1024 + h * 128, (const bf16_t*)(ws + WS_KG) + (size_t)b * SEQ * 256 + (h >> 2) * 128, nullptr,
                                               (const bf16_t*)(ws + WS_VG) + (size_t)b * SEQ * 256 + (h >> 2) * 128, Z + r0 * 3072 + 1024 + h * 128, SEQ, (LAS char*)lds); }
#endif
#undef DECODE_UNIT
#ifndef SKIP_MEM
        for (int u = bid; u < NBATCH * 4 * 32; u += G) { const int bh = u >> 5, rb = u & 31;
            mem_attn_block((const bf16_t*)(ws + WS_QM), (const bf16_t*)(ws + WS_KM), (const bf16_t*)(ws + WS_VMT), Z, bh >> 2, bh & 3, rb, lds, tid); }
#endif
    }
    SEAM(4);


#ifdef PROBE_CHECK
    if (lo == 20) {
        unsigned* cnt = (unsigned*)(ws + WS_ZERO + 4096 * 64 * 2 - 32);
        { const unsigned sidx = (unsigned)(bid * 512 + tid); const int tok = (int)((sidx * 2654435761u >> 7) % 2560u), c = (int)((sidx * 40503u >> 2) & 1023u); const int b_ = tok >> 8, key = tok & 255; const int pos = (key & ~31) + 8 * ((key >> 2) & 3) + 4 * ((key >> 4) & 1) + (key & 3);
          const bf16_t a_ = ((const bf16_t*)(ws + WS_VMT))[(size_t)c * MEMROWS + b_ * 256 + pos], b2_ = ((const bf16_t*)(ws + WS_VM))[(size_t)tok * 1024 + c]; if (a_ != b2_) atomicAdd(cnt + ((c & 128) ? 2 : 3), 1u); }
        const int w = bid * 8 + wave; const int r = (int)(((long)w * 977 + 13) % T); const int b = r >> 12; const int br = PROBE_BR;
        const int h = w & (br == 2 ? 3 : 7);
        const bf16_t* Qp; const bf16_t* Kp; const bf16_t* Xp = nullptr; const bf16_t* Vp; int ldk, ldv, dk, nk; float scale;
        if (br == 0) { Qp = QMLA + (size_t)r * 1536 + h * 192; Kp = (const bf16_t*)(ws + WS_KN) + (size_t)b * SEQ * 1024 + h * 128; Xp = (const bf16_t*)(ws + WS_KPE) + (size_t)b * SEQ * 64; Vp = (const bf16_t*)(ws + WS_VN) + (size_t)b * SEQ * 1024 + h * 128; ldk = 1024; ldv = 1024; dk = 128; nk = 4096; scale = 0.07216878364870323f; }
        else if (br == 1) { Qp = (const bf16_t*)(ws + WS_QG) + (size_t)r * 1024 + h * 128; Kp = (const bf16_t*)(ws + WS_KG) + (size_t)b * SEQ * 256 + (h >> 2) * 128; Vp = (const bf16_t*)(ws + WS_VG) + (size_t)b * SEQ * 256 + (h >> 2) * 128; ldk = 256; ldv = 256; dk = 128; nk = 4096; scale = 0.08838834764831843f; }
        else { Qp = (const bf16_t*)(ws + WS_QM) + (size_t)r * 1024 + h * 256; Kp = (const bf16_t*)(ws + WS_KM) + (size_t)b * 256 * 1024 + h * 256; Vp = (const bf16_t*)(ws + WS_VM) + (size_t)b * 256 * 1024 + h * 256 + 128; ldk = 1024; ldv = 1024; dk = 256; nk = 256; scale = 0.0625f; }
        float p[64]; float m = -1e30f;
#pragma unroll
        for (int j = 0; j < 64; ++j) { const int key = lane + 64 * j; float sdot = -1e30f;
            if (key < nk) { sdot = 0.f; for (int d = 0; d < dk; ++d) sdot += __uint_as_float((unsigned)Qp[d] << 16) * __uint_as_float((unsigned)Kp[(size_t)key * ldk + d] << 16);
                if (Xp) for (int d = 0; d < 64; ++d) sdot += __uint_as_float((unsigned)Qp[128 + d] << 16) * __uint_as_float((unsigned)Xp[(size_t)key * 64 + d] << 16);
                sdot *= scale; }
            p[j] = sdot; m = fmaxf(m, sdot); }
#pragma unroll
        for (int o = 1; o < 64; o <<= 1) m = fmaxf(m, __shfl_xor(m, o));
        float l = 0.f;
#pragma unroll
        for (int j = 0; j < 64; ++j) { p[j] = (lane + 64 * j < nk) ? __expf(p[j] - m) : 0.f; l += p[j]; }
        l = wave_sum(l);
        int bad = 0;
        const int zc = br * 1024 + (br == 2 ? h * 256 + 128 : h * 128);
        for (int d = 0; d < 128; ++d) { float acc = 0.f;
#pragma unroll
            for (int j = 0; j < 64; ++j) { const int key = lane + 64 * j; if (key < nk) acc += p[j] * __uint_as_float((unsigned)Vp[(size_t)key * ldv + d] << 16); }
            acc = wave_sum(acc) / l;
            float zd = 0.f; const bf16_t* wz = (const bf16_t*)(ws + WS_WIN) + (size_t)(3584 + zc + d) * 2048;
            for (int k = lane; k < 2048; k += 64) zd += __uint_as_float((unsigned)H[(size_t)r * 2048 + k] << 16) * __uint_as_float((unsigned)wz[k] << 16);
            zd = wave_sum(zd); const float sz = zd / (1.f + __expf(-zd)); const float szb = __uint_as_float(cvt_pk_bf16(sz, 0.f) << 16);
#ifdef PROBE_NOZ
            const float uref = acc; (void)szb;
#else
            const float uref = acc * szb;
#endif
            const float um = __uint_as_float((unsigned)((const bf16_t*)(ws + WS_Z))[(size_t)r * 3072 + zc + d] << 16);
            if (fabsf(um - uref) > 0.02f * fabsf(uref) + 0.0003f) ++bad; }
        if (lane == 0) { atomicAdd(cnt + 0, 1u); if (bad > 0) atomicAdd(cnt + 1, 1u); }
    }
    if (lo == 21 && bid < 64) {
        unsigned* cnt = (unsigned*)(ws + WS_ZERO + 4096 * 64 * 2 - 32);
        const int w = bid * 8 + wave; const int r = (int)(((long)w * 977 + 13) % T), c = (w * 1543 + 11) % 6144;
        float gd = 0.f; const bf16_t* wg = (const bf16_t*)(ws + WS_WGL) + (size_t)c * 2048;
        for (int k = lane; k < 2048; k += 64) gd += __uint_as_float((unsigned)H[(size_t)r * 2048 + k] << 16) * __uint_as_float((unsigned)wg[k] << 16);
        gd = wave_sum(gd); const float gref = 1.f / (1.f + __expf(-gd)); const float gm = __uint_as_float((unsigned)((const bf16_t*)(ws + WS_GL))[(size_t)r * 6144 + c] << 16);
        if (lane == 0 && fabsf(gm - gref) > 0.005f) atomicAdd(cnt + 4, 1u);
    }
    if (lo == 22 && bid < 64) {
        unsigned* cnt = (unsigned*)(ws + WS_ZERO + 4096 * 64 * 2 - 32);
        const int w = bid * 8 + wave; const int r = (int)(((long)w * 977 + 13) % T), c = (w * 389 + 7) & 2047;
        const bf16_t* GLb = (const bf16_t*)(ws + WS_GL); const bf16_t* Zb = (const bf16_t*)(ws + WS_Z); const bf16_t* WBRb = (const bf16_t*)(ws + WS_WBR); const bf16_t* MG = (const bf16_t*)(ws + WS_MERGED);
        const bf16_t* WO = (const bf16_t*)(ws + WS_WOUT);
        float mref = 0.f;
        for (int i = 0; i < 3; ++i) { float d = 0.f; for (int k = lane; k < 1024; k += 64) d += __uint_as_float((unsigned)Zb[(size_t)r * 3072 + i * 1024 + k] << 16) * __uint_as_float((unsigned)WBRb[((size_t)i * 2048 + c) * 1024 + k] << 16);
            d = wave_sum(d); mref += d * __uint_as_float((unsigned)GLb[(size_t)r * 6144 + i * 2048 + c] << 16); }
        const float mm = __uint_as_float((unsigned)MG[(size_t)r * 2048 + c] << 16);
        float yd = 0.f; for (int k = lane; k < 2048; k += 64) yd += __uint_as_float((unsigned)MG[(size_t)r * 2048 + k] << 16) * __uint_as_float((unsigned)WO[(size_t)c * 2048 + k] << 16);
        yd = wave_sum(yd); const float* xr = r < TP ? xp + (size_t)r * DM : xs + (size_t)(r - TP) * DM; const float yref = xr[c] + yd; const float ym = args.out[(size_t)r * DM + c];
        if (lane == 0) {
            if (fabsf(mm - mref) > 0.015f * fabsf(mref) + 0.0003f) atomicAdd(cnt + 5, 1u);
            if (fabsf(ym - yref) > 0.001f) atomicAdd(cnt + 6, 1u); }
    }
#endif
    if (IN(5)) {
        for (int i = 0; i < 3; ++i) {
            pg8::Gemm g{(const bf16_t*)(ws + WS_H8), (const bf16_t*)(ws + WS_WGL) + (size_t)i * 2048 * 1024, 1024, 1024, T, 2048, 1024}; pg8::StaticOrder S; S.init(T, 2048, G, bid);
            pg8::EpiGL E{(bf16_t*)(ws + WS_GL) + i * 2048, 1.f / (H8_SCALE * W8_SCALE)}; pg8::gemm_phase<pg8::EpiGL, pg8::StaticOrder, true>(lds, g, S, E);
        }
    }
    if constexpr (COOP) { __syncthreads(); }

    if (IN(6)) {
#ifndef PROBE_ZERO
#define PROBE_ZERO -1
#endif
        for (int i = 0; i < 3; ++i) {
            if (i == PROBE_ZERO) continue;
            pg8::Gemm g{(const bf16_t*)(ws + WS_Z) + i * 1024, (const bf16_t*)(ws + WS_WBR) + (size_t)i * 2048 * 1024, 3072, 1024, T, 2048, 1024}; pg8::StaticOrder S; S.init(T, 2048, G, bid);
            pg8::EpiBR E{(const bf16_t*)(ws + WS_GL) + i * 2048, (bf16_t*)(ws + WS_MERGED), i == (PROBE_ZERO == 0 ? 1 : 0)}; pg8::gemm_phase(lds, g, S, E);
        }
    }
    SEAM(6);

    if (IN(7)) {
        pg8::Gemm g{(const bf16_t*)(ws + WS_MERGED), (const bf16_t*)(ws + WS_WOUT), 2048, 2048, T, 2048, 2048}; pg8::StaticOrder S; S.init(T, 2048, G, bid);
        pg8::EpiOut E{xp, xs, args.out, (float*)(ws + WS_SSQ)}; pg8::gemm_phase(lds, g, S, E);
    }
    SEAM(7);


#ifdef PROBE_SCAN
    if (lo == 30) {
        unsigned* cnt = (unsigned*)(ws + WS_ZERO + 4096 * 64 * 2 - 32);
        const size_t gt = (size_t)bid * 512 + tid, gn = (size_t)G * 512;
        unsigned f = 0;
        { const bf16_t* p = (const bf16_t*)(ws + WS_WIN); const size_t n = (WS_TABG - WS_WIN) / 2; for (size_t i = gt; i < n; i += gn) { const float v = __uint_as_float((unsigned)p[i] << 16); if (!(fabsf(v) < 0.5f)) f |= 1u; } }
        { const bf16_t* p = (const bf16_t*)(ws + WS_MERGED); const size_t n = (size_t)T * 2048; for (size_t i = gt; i < n; i += gn) { const float v = __uint_as_float((unsigned)p[i] << 16); if (!(fabsf(v) < 2.0f)) f |= 2u; } }
        { const bf16_t* p = (const bf16_t*)(ws + WS_Z); const size_t n = (size_t)T * 3072; for (size_t i = gt; i < n; i += gn) { const float v = __uint_as_float((unsigned)p[i] << 16); if (!(fabsf(v) < 4.0f)) f |= 4u; } }
        { const bf16_t* p = (const bf16_t*)(ws + WS_GL); const size_t n = (size_t)T * 6144; for (size_t i = gt; i < n; i += gn) { const float v = __uint_as_float((unsigned)p[i] << 16); if (!(v >= 0.f && v <= 1.f)) f |= 8u; } }
        if (f & 1u) atomicAdd(cnt + 1, 1u); if (f & 2u) atomicAdd(cnt + 2, 1u); if (f & 4u) atomicAdd(cnt + 3, 1u); if (f & 8u) atomicAdd(cnt + 4, 1u);
        if (tid == 0) atomicAdd(cnt + 0, 1u);
    }
#endif
#define PH_FINAL 8
    if (IN(PH_FINAL)) {
        const float* gf = args.in[16];
#if defined(PROBE_SCAN)
        const unsigned* cntp = (const unsigned*)(ws + WS_ZERO + 4096 * 64 * 2 - 32);
        unsigned nn[5];
        for (int q = 0; q < 5; ++q) nn[q] = __hip_atomic_load(cntp + q, __ATOMIC_RELAXED, __HIP_MEMORY_SCOPE_AGENT);
        const float pscale = 1.f + (nn[0] == (unsigned)G ? 0.05f : 0.f) + (nn[1] > 0u ? 0.1f : 0.f) + (nn[2] > 0u ? 0.2f : 0.f) + (nn[3] > 0u ? 0.4f : 0.f) + (nn[4] > 0u ? 0.8f : 0.f);
#elif defined(PROBE_CHECK)
        const unsigned* cntp = (const unsigned*)(ws + WS_ZERO + 4096 * 64 * 2 - 32);
        unsigned nn[7];
        for (int q = 0; q < 7; ++q) nn[q] = __hip_atomic_load(cntp + q, __ATOMIC_RELAXED, __HIP_MEMORY_SCOPE_AGENT);
        const float pscale = 1.f + (nn[0] == 2048u ? 0.05f : 0.f) + (float)nn[1] * 0.01f;
#else
        const float pscale = 1.f;
#endif
        for (int r = gw; r < T; r += NGW) {
            f32x4* orow = (f32x4*)(args.out + (size_t)r * DM);
            f32x4 v[8]; float sq = 0.f;
#pragma unroll
            for (int j = 0; j < 8; ++j) { v[j] = orow[lane + 64 * j]; sq += (v[j][0] * v[j][0] + v[j][1] * v[j][1]) + (v[j][2] * v[j][2] + v[j][3] * v[j][3]); }
#ifdef PROBE_NORSTD
            const float rstd = pscale + 0.f * wave_sum(sq);
#else
            const float rstd = pscale / sqrtf(wave_sum(sq) * (1.f / DM) + EPS);
#endif
#pragma unroll
            for (int j = 0; j < 8; ++j) {
#ifdef PROBE_NOGAIN
                const f32x4 gg = (f32x4){1.f, 1.f, 1.f, 1.f};
#else
                const f32x4 gg = ((const f32x4*)gf)[lane + 64 * j];
#endif
                f32x4 w; w[0] = v[j][0] * rstd * gg[0]; w[1] = v[j][1] * rstd * gg[1]; w[2] = v[j][2] * rstd * gg[2]; w[3] = v[j][3] * rstd * gg[3]; orow[lane + 64 * j] = w; }
        }
    }
    __builtin_amdgcn_fence(__ATOMIC_RELEASE, "agent");
#undef IN
#undef SEAM
}

extern "C" void kernel_launch(void* const* d_in, const int* in_sizes, int n_in, void* d_out, int out_size, void* d_ws, size_t ws_size, hipStream_t stream) {
    static int grid = 0;
    if (grid == 0) {
        if (n_in != 17 || out_size != T * DM || ws_size < WS_END) { fprintf(stderr, "kernel_launch: unexpected shapes: n_in %d out %d ws %zu (need %zu)\n", n_in, out_size, ws_size, (size_t)WS_END); grid = -1; return; }
        int dev = 0, cus = 0;
        if (hipGetDevice(&dev) != hipSuccess || hipDeviceGetAttribute(&cus, hipDeviceAttributeMultiprocessorCount, dev) != hipSuccess) { grid = -1; return; }
        if (hipFuncSetAttribute((const void*)mk_fwd<MK_COOP != 0>, hipFuncAttributeMaxDynamicSharedMemorySize, LDS_BYTES) != hipSuccess) { fprintf(stderr, "kernel_launch: hipFuncSetAttribute failed\n"); grid = -1; return; }
        int per_cu = 0;
        if (hipOccupancyMaxActiveBlocksPerMultiprocessor(&per_cu, (const void*)mk_fwd<MK_COOP != 0>, 512, LDS_BYTES) != hipSuccess || per_cu < 1) { fprintf(stderr, "kernel_launch: occupancy query says %d\n", per_cu); per_cu = 1; }
        (void)hipGetLastError();
        grid = cus;
    }
    if (grid < 0) return;
    Args a{};
    for (int i = 0; i < 17; ++i) a.in[i] = (const float*)d_in[i];
    a.out = (float*)d_out; a.ws = (unsigned char*)d_ws;
#if MK_COOP
    (void)hipMemsetAsync((char*)d_ws + WS_BAR, 0, 256, stream);
    a.ph_lo = 0; a.ph_hi = NPHASE;
    void* kargs[] = {&a};
    hipError_t e = hipLaunchCooperativeKernel((const void*)mk_fwd<true>, dim3(grid), dim3(512), kargs, LDS_BYTES, stream);
    if (e != hipSuccess) fprintf(stderr, "kernel_launch: cooperative launch failed: %s (grid %d)\n", hipGetErrorString(e), grid);
#else
#if defined(PROBE_SCAN)
    const int seq_[10] = {0, 1, 2, 3, 4, 5, 6, 7, 30, 8};
    for (int q = 0; q < 10; ++q) { a.ph_lo = seq_[q]; a.ph_hi = seq_[q] + 1; hipLaunchKernelGGL(mk_fwd<false>, dim3(grid), dim3(512), LDS_BYTES, stream, a); }
#elif defined(PROBE_CHECK)
    const int seq_[12] = {0, 1, 2, 3, 4, 20, 5, 21, 6, 7, 22, 8};
    for (int q = 0; q < 12; ++q) { a.ph_lo = seq_[q]; a.ph_hi = seq_[q] + 1; hipLaunchKernelGGL(mk_fwd<false>, dim3(grid), dim3(512), LDS_BYTES, stream, a); }
#else
    for (int p = 0; p < NPHASE; ++p) { a.ph_lo = p; a.ph_hi = p + 1; hipLaunchKernelGGL(mk_fwd<false>, dim3(grid), dim3(512), LDS_BYTES, stream, a); }
#endif
#endif
}
```

```cpp
#include <hip/hip_runtime.h>
#include <hip/hip_cooperative_groups.h>
#include <cstdio>
#include <cstdint>
namespace cg = cooperative_groups;

#define PROBE_BETA 1.0f
#ifndef MK_COOP
#define MK_COOP 1
#endif

#define LAS __attribute__((address_space(3)))
typedef unsigned short bf16_t;
typedef short bf16x8 __attribute__((ext_vector_type(8)));
typedef short s16x4 __attribute__((ext_vector_type(4)));
typedef float f32x2 __attribute__((ext_vector_type(2)));
typedef float f32x4 __attribute__((ext_vector_type(4)));
typedef float f32x16 __attribute__((ext_vector_type(16)));
typedef unsigned u32x2 __attribute__((ext_vector_type(2)));
typedef unsigned u32x4 __attribute__((ext_vector_type(4)));
typedef long l64x2 __attribute__((ext_vector_type(2)));

constexpr int T = 40960, TP = 32768, DM = 2048, SEQ = 4096, NBATCH = 10, MEMROWS = 2560;
constexpr float EPS = 1e-6f;
constexpr int NP1 = 6656;
constexpr size_t WS_WIN = 0;
constexpr size_t WS_WGL = WS_WIN + (size_t)NP1 * 2048 * 2;
constexpr size_t WS_WQB = WS_WGL + (size_t)6144 * 2048 * 2;
constexpr size_t WS_WKVB = WS_WQB + (size_t)1536 * 512 * 2;
constexpr size_t WS_WMKV = WS_WKVB + (size_t)2048 * 256 * 2;
constexpr size_t WS_WBR = WS_WMKV + (size_t)2048 * 2048 * 2;
constexpr size_t WS_WOUT = WS_WBR + (size_t)3 * 2048 * 1024 * 2;
constexpr size_t WS_TABG = WS_WOUT + (size_t)2048 * 2048 * 2;
constexpr size_t WS_TABM = WS_TABG + 64 * 32 * 8;
constexpr size_t WS_GQP = WS_TABM + 64 * 16 * 8;
constexpr size_t WS_GKP = WS_GQP + 512;
constexpr size_t WS_BAR = WS_GKP + 512;
constexpr size_t WS_ZERO = WS_BAR + 256;
constexpr size_t WS_SSQ = WS_ZERO + 4096 * 64 * 2;
constexpr size_t WS_Z = WS_SSQ + (size_t)T * 32 * 4;
constexpr size_t WS_R = WS_Z + (size_t)T * 3072 * 2;
constexpr size_t WS_CQ = WS_R;
constexpr size_t WS_CKV = WS_CQ + (size_t)T * 512 * 2;
constexpr size_t WS_KPE = WS_CKV + (size_t)T * 256 * 2;
constexpr size_t WS_QG = WS_KPE + (size_t)T * 64 * 2;
constexpr size_t WS_KG = WS_QG + (size_t)T * 1024 * 2;
constexpr size_t WS_VG = WS_KG + (size_t)T * 256 * 2;
constexpr size_t WS_QM = WS_VG + (size_t)T * 256 * 2;
constexpr size_t WS_KN = WS_QM + (size_t)T * 1024 * 2;
constexpr size_t WS_VN = WS_KN + (size_t)T * 1024 * 2;
constexpr size_t WS_KM = WS_VN + (size_t)T * 1024 * 2;
constexpr size_t WS_VM = WS_KM + (size_t)MEMROWS * 1024 * 2;
constexpr size_t WS_VMT = WS_VM + (size_t)MEMROWS * 1024 * 2;
constexpr size_t WS_REND = WS_VMT + (size_t)MEMROWS * 1024 * 2;
constexpr size_t WS_GL = WS_R;
constexpr size_t WS_MERGED = WS_GL + (size_t)T * 6144 * 2;
constexpr size_t WS_END = WS_MERGED + (size_t)T * 2048 * 2;
constexpr size_t WS_H8 = WS_MERGED;
constexpr float H8_SCALE = 16.f, W8_SCALE = 64.f;
static_assert(WS_REND <= WS_MERGED, "region R inside GL overlay");
static_assert(WS_END <= (size_t)1 << 30, "d_ws map fits 1 GiB");
constexpr size_t DO_H = 0;
constexpr size_t DO_QMLA = DO_H + (size_t)T * 2048 * 2;
constexpr size_t DO_MN = DO_QMLA + (size_t)T * 1536 * 2;
static_assert(DO_MN + (size_t)MEMROWS * 2048 * 2 <= (size_t)T * 2048 * 4, "d_out scratch");

constexpr int LDS_BYTES = 131072 + 512;

typedef float f32x2_cv __attribute__((ext_vector_type(2)));
typedef __bf16 bf16x2_cv __attribute__((ext_vector_type(2)));
__device__ __forceinline__ unsigned cvt_pk_bf16(float lo, float hi) { unsigned r; asm volatile("v_cvt_pk_bf16_f32 %0, %1, %2" : "=v"(r) : "v"(lo), "v"(hi)); return r; }
__device__ __forceinline__ unsigned cvt_pk_bf16_safe(float lo, float hi) { const f32x2_cv v = {lo, hi}; const bf16x2_cv b = __builtin_convertvector(v, bf16x2_cv); return __builtin_bit_cast(unsigned, b); }
__device__ __forceinline__ u32x4 ld16_coherent(const void* p) { u32x4 v; asm volatile("global_load_dwordx4 %0, %1, off sc1\n\ts_waitcnt vmcnt(0)" : "=v"(v) : "v"(p) : "memory"); return v; }
__device__ __forceinline__ float bf_lo(unsigned w) { return __uint_as_float(w << 16); }
__device__ __forceinline__ float bf_hi(unsigned w) { return __uint_as_float(w & 0xffff0000u); }
__device__ __forceinline__ float wave_sum(float v) {
#pragma unroll
    for (int o = 1; o < 64; o <<= 1) v += __shfl_xor(v, o);
    return v;
}
__device__ __forceinline__ float fast_sigmoid(float v) { return __builtin_amdgcn_rcpf(1.f + __builtin_amdgcn_exp2f(-1.4426950408889634f * v)); }
__device__ __forceinline__ float fast_silu(float v) { return v * fast_sigmoid(v); }

namespace pg8 {
constexpr int BM = 256, BK = 64, HALF = 128, HTB = HALF * BK * 2, STAGE_BYTES = 8 * HTB, NXCD = 8, WGM = 8;
__host__ __device__ __forceinline__ int lds_byte(int r, int c) { const int st = (r >> 4) * 2 + (c >> 5), rr = r & 15, cc = c & 31, ob = rr * 64 + cc * 2; return st * 1024 + (ob ^ (((ob >> 9) & 1) << 5)); }
__host__ __device__ __forceinline__ void stage_rc(int b, int& R, int& C) { const int st = b / 1024, sb = b % 1024, swz = sb ^ (((sb >> 9) & 1) << 5); R = (st >> 1) * 16 + swz / 64; C = (st & 1) * 32 + (swz % 64) / 2; }
__host__ __device__ __forceinline__ int perm32(int rho) { const int n = rho >> 4, i = rho & 15; return 8 * (i >> 2) + 4 * n + (i & 3); }

struct Unit { int pm, pn; };
struct Gemm { const bf16_t* A; const bf16_t* Bt; int lda, ldb, M, N, K; };

struct StaticOrder {
    int nM, nN, nwg, G, c;
    __device__ void init(int M, int N, int G_, int c_) { nM = M / BM; nN = N / BM; nwg = nM * nN; G = G_; c = c_; }
    __device__ bool next(int i, Unit& u) const {
        const long L = (long)i * G + c; if (L >= nwg) return false;
        int wgid = (int)L; { const int q = nwg / NXCD, r = nwg % NXCD, xcd = wgid % NXCD, off = wgid / NXCD; wgid = (xcd < r ? xcd * (q + 1) : r * (q + 1) + (xcd - r) * q) + off; }
        const int nig = WGM * nN, gid = wgid / nig, fm = gid * WGM, gsz = (nM - fm) < WGM ? (nM - fm) : WGM;
        u.pm = fm + ((wgid % nig) % gsz); u.pn = (wgid % nig) / gsz; return true;
    }
};

template <class Epi, class Sched, bool FP8 = false>
__device__ __forceinline__ void gemm_phase(LAS unsigned char* lds, const Gemm g, const Sched& S, const Epi& E) {
    const int tid = threadIdx.x, wid = __builtin_amdgcn_readfirstlane(tid >> 6), lane = tid & 63, wr = wid >> 2, wc = wid & 3, fr = lane & 15, fq = lane >> 4;
    const int K = g.K, nt = K / BK;
    unsigned voffA[2], voffB[2];
#pragma unroll
    for (int i = 0; i < 2; ++i) { int R, C; stage_rc(tid * 16 + i * 8192, R, C); const int Rb = Epi::PERM ? ((R & ~31) + perm32(R & 31)) : R;
        voffA[i] = (unsigned)(R * g.lda + C) * 2u; voffB[i] = (unsigned)(Rb * g.ldb + C) * 2u; }
    const size_t kstep = (size_t)(BK * 2);
    const size_t hstepA = (size_t)HALF * g.lda * 2, hstepB = (size_t)HALF * g.ldb * 2;
    const size_t tstepA = 2 * hstepA, tstepB = 2 * hstepB;
    const unsigned ldsw = (unsigned)wid * 1024u;
    const int aoff = lds_byte(wr * 64 + fr, fq * 8), boff = lds_byte(wc * 32 + fr, fq * 8);
#define PG8_SA(b, h) (((b) * 2 + (h)) * HTB)
#define PG8_SB(b, h) ((4 + (b) * 2 + (h)) * HTB)
#define PG8_STAGE(bufoff, gbase, voff) do { _Pragma("unroll") for (int _i = 0; _i < 2; ++_i) \
        __builtin_amdgcn_global_load_lds((const unsigned*)((const char*)(gbase) + (voff)[_i]), (LAS unsigned*)(lds + (bufoff) + ldsw + _i * 8192), 16, 0, 0); } while (0)
#define PG8_LDA(dst, b, h) do { _Pragma("unroll") for (int m = 0; m < 4; ++m) _Pragma("unroll") for (int k = 0; k < 2; ++k) dst[m][k] = *(const LAS bf16x8*)(lds + PG8_SA(b, h) + aoff + m * 2048 + k * 1024); } while (0)
#define PG8_LDB(dst, b, h) do { _Pragma("unroll") for (int n = 0; n < 2; ++n) _Pragma("unroll") for (int k = 0; k < 2; ++k) dst[n][k] = *(const LAS bf16x8*)(lds + PG8_SB(b, h) + boff + n * 2048 + k * 1024); } while (0)
#define PG8_MMA(ai, bj, At, Bt) do { __builtin_amdgcn_s_setprio(1); _Pragma("unroll") for (int m = 0; m < 4; ++m) _Pragma("unroll") for (int n = 0; n < 2; ++n) _Pragma("unroll") for (int k = 0; k < 2; ++k) { \
        if constexpr (FP8) { const l64x2 b_ = __builtin_bit_cast(l64x2, Bt[n][k]), a_ = __builtin_bit_cast(l64x2, At[m][k]); \
            acc[ai][bj][m][n] = __builtin_amdgcn_mfma_f32_16x16x32_fp8_fp8(b_[0], a_[0], acc[ai][bj][m][n], 0, 0, 0); \
            acc[ai][bj][m][n] = __builtin_amdgcn_mfma_f32_16x16x32_fp8_fp8(b_[1], a_[1], acc[ai][bj][m][n], 0, 0, 0); } \
        else acc[ai][bj][m][n] = __builtin_amdgcn_mfma_f32_16x16x32_bf16(Bt[n][k], At[m][k], acc[ai][bj][m][n], 0, 0, 0); } __builtin_amdgcn_s_setprio(0); } while (0)
#define PG8_WAIT_V(n) asm volatile("s_waitcnt vmcnt(" #n ")" ::: "memory")
#define PG8_WAIT_L(n) asm volatile("s_waitcnt lgkmcnt(" #n ")" ::: "memory")
#define PG8_BAR __builtin_amdgcn_s_barrier()
#define PG8_SCHED __builtin_amdgcn_sched_barrier(0)
    Unit cur, nxt; int ui = 0;
    if (!S.next(0, cur)) return;
    f32x4 acc[2][2][4][2];
#pragma unroll
    for (int a = 0; a < 2; ++a)
#pragma unroll
        for (int b = 0; b < 2; ++b)
#pragma unroll
            for (int m = 0; m < 4; ++m)
#pragma unroll
                for (int n = 0; n < 2; ++n) acc[a][b][m][n] = (f32x4){0.f, 0.f, 0.f, 0.f};
    bf16x8 At[4][2], B0[2][2], B1[2][2];
    const char* cA = (const char*)g.A + (size_t)cur.pm * tstepA; const char* cB = (const char*)g.Bt + (size_t)cur.pn * tstepB;
    PG8_STAGE(PG8_SB(0, 0), cB, voffB); PG8_STAGE(PG8_SB(0, 1), cB + hstepB, voffB); PG8_STAGE(PG8_SA(0, 0), cA, voffA); PG8_STAGE(PG8_SA(0, 1), cA + hstepA, voffA);
    if (wr == 1) PG8_BAR;
    PG8_WAIT_V(2); PG8_BAR;
    PG8_STAGE(PG8_SB(1, 0), cB + kstep, voffB); PG8_STAGE(PG8_SA(1, 0), cA + kstep, voffA); PG8_STAGE(PG8_SB(1, 1), cB + hstepB + kstep, voffB);
    PG8_WAIT_V(6); PG8_BAR;
    for (;;) {
        const bool has_next = S.next(ui + 1, nxt);
        const char* nA = has_next ? (const char*)g.A + (size_t)nxt.pm * tstepA : cA; const char* nB = has_next ? (const char*)g.Bt + (size_t)nxt.pn * tstepB : cB;
        for (int t = 0; t < nt; t += 2) {
            const bool last = (t == nt - 2);
            const char* a1 = cA + (size_t)(t + 1) * kstep;
            const char* a2 = last ? nA : cA + (size_t)(t + 2) * kstep; const char* b2 = last ? nB : cB + (size_t)(t + 2) * kstep;
            const char* a3 = a2 + kstep; const char* b3 = b2 + kstep;
            PG8_LDB(B0, 0, 0); PG8_LDB(B1, 0, 1); PG8_SCHED; PG8_LDA(At, 0, 0); PG8_STAGE(PG8_SA(1, 1), a1 + hstepA, voffA);
            PG8_WAIT_V(8); PG8_WAIT_L(0); PG8_BAR; PG8_MMA(0, 0, At, B0); PG8_MMA(0, 1, At, B1); PG8_BAR; PG8_SCHED;
            PG8_LDA(At, 0, 1); PG8_STAGE(PG8_SB(0, 0), b2, voffB); PG8_STAGE(PG8_SB(0, 1), b2 + hstepB, voffB); PG8_STAGE(PG8_SA(0, 0), a2, voffA);
            PG8_WAIT_V(8); PG8_WAIT_L(0); PG8_BAR; PG8_MMA(1, 0, At, B0); PG8_MMA(1, 1, At, B1); PG8_BAR; PG8_SCHED;
            PG8_LDB(B0, 1, 0); PG8_LDB(B1, 1, 1); PG8_SCHED; PG8_LDA(At, 1, 0); PG8_STAGE(PG8_SA(0, 1), a2 + hstepA, voffA);
            PG8_WAIT_V(8); PG8_WAIT_L(0); PG8_BAR; PG8_MMA(0, 0, At, B0); PG8_MMA(0, 1, At, B1); PG8_BAR; PG8_SCHED;
            PG8_LDA(At, 1, 1); PG8_STAGE(PG8_SB(1, 0), b3, voffB); PG8_STAGE(PG8_SB(1, 1), b3 + hstepB, voffB); PG8_STAGE(PG8_SA(1, 0), a3, voffA);
            PG8_WAIT_V(8); PG8_WAIT_L(0); PG8_BAR; PG8_MMA(1, 0, At, B0); PG8_MMA(1, 1, At, B1); PG8_BAR; PG8_SCHED;
        }
        if (wr == 0) PG8_BAR;
        E(acc, cur, wr, wc, fr, fq);
        if (!has_next) break;
#pragma unroll
        for (int a = 0; a < 2; ++a)
#pragma unroll
            for (int b = 0; b < 2; ++b)
#pragma unroll
                for (int m = 0; m < 4; ++m)
#pragma unroll
                    for (int n = 0; n < 2; ++n) acc[a][b][m][n] = (f32x4){0.f, 0.f, 0.f, 0.f};
        cur = nxt; cA = nA; cB = nB; ++ui;
        if (wr == 1) PG8_BAR;
    }
    PG8_WAIT_V(0);
    PG8_BAR;
#undef PG8_SA
#undef PG8_SB
#undef PG8_STAGE
#undef PG8_LDA
#undef PG8_LDB
#undef PG8_MMA
#undef PG8_WAIT_V
#undef PG8_WAIT_L
#undef PG8_BAR
#undef PG8_SCHED
}

template <class F> __device__ __forceinline__ void epi_loop(const f32x4 (&acc)[2][2][4][2], const Unit& u, int wr, int wc, int fr, int fq, F f) {
#pragma unroll
    for (int ai = 0; ai < 2; ++ai)
#pragma unroll
        for (int m = 0; m < 4; ++m) { const int row = u.pm * BM + ai * HALF + wr * 64 + m * 16 + fr;
#pragma unroll
            for (int bj = 0; bj < 2; ++bj) { const int lc = bj * HALF + wc * 32 + 8 * fq; f(row, lc, acc[ai][bj][m][0], acc[ai][bj][m][1]); } }
}
#define EPI_BEGIN epi_loop(acc, u, wr, wc, fr, fq, [&](int row, int lc, f32x4 v0, f32x4 v1) __attribute__((always_inline)) {
#define EPI_END });

__device__ __forceinline__ u32x4 pack8(f32x4 v0, f32x4 v1) { u32x4 w; w.x = cvt_pk_bf16(v0[0], v0[1]); w.y = cvt_pk_bf16(v0[2], v0[3]); w.z = cvt_pk_bf16(v1[0], v1[1]); w.w = cvt_pk_bf16(v1[2], v1[3]); return w; }

struct EpiP1 {
    static constexpr bool PERM = true;
    unsigned char* ws;
    __device__ __forceinline__ void operator()(const f32x4 (&acc)[2][2][4][2], const Unit& u, int wr, int wc, int fr, int fq) const {
        const int pn = u.pn; bf16_t* dst; int ldc, c0; int mode = 0;
        if (pn < 2) { dst = (bf16_t*)(ws + WS_CQ); ldc = 512; c0 = pn * 256; }
        else if (pn == 2) { dst = (bf16_t*)(ws + WS_CKV); ldc = 256; c0 = 0; }
        else if (pn == 3) { dst = (bf16_t*)(ws + WS_KPE); ldc = 64; c0 = 0; mode = 2; }
        else if (pn < 8) { dst = (bf16_t*)(ws + WS_QG); ldc = 1024; c0 = (pn - 4) * 256; }
        else if (pn == 8) { dst = (bf16_t*)(ws + WS_KG); ldc = 256; c0 = 0; }
        else if (pn == 9) { dst = (bf16_t*)(ws + WS_VG); ldc = 256; c0 = 0; }
        else if (pn < 14) { dst = (bf16_t*)(ws + WS_QM); ldc = 1024; c0 = (pn - 10) * 256; }
        else { dst = (bf16_t*)(ws + WS_Z); ldc = 3072; c0 = (pn - 14) * 256; mode = 1; }
        EPI_BEGIN
            if (mode == 1) {
#pragma unroll
                for (int e = 0; e < 4; ++e) { v0[e] = fast_silu(v0[e]); v1[e] = fast_silu(v1[e]); } }
            if (mode != 2 || lc < 64) *(u32x4*)(dst + (size_t)row * ldc + c0 + lc) = pack8(v0, v1);
        EPI_END
    }
};
struct EpiSplit {
    static constexpr bool PERM = true;
    bf16_t* d0; bf16_t* d1; int ldc;
    __device__ __forceinline__ void operator()(const f32x4 (&acc)[2][2][4][2], const Unit& u, int wr, int wc, int fr, int fq) const {
        bf16_t* dst = u.pn < 4 ? d0 : d1; const int c0 = (u.pn & 3) * 256;
        EPI_BEGIN *(u32x4*)(dst + (size_t)row * ldc + c0 + lc) = pack8(v0, v1); EPI_END
    }
};
struct EpiQ {
    static constexpr bool PERM = true;
    bf16_t* dst; const f32x2* tabm;
    __device__ __forceinline__ void operator()(const f32x4 (&acc)[2][2][4][2], const Unit& u, int wr, int wc, int fr, int fq) const {
        EPI_BEGIN
            const int c = u.pn * 256 + lc; const int d = c % 192;
            if (d >= 128) { const int p0 = d - 128, a = p0 >> 5, i0 = (p0 & 31) >> 1; const int s = row & 4095; const int pos = a ? (s & 63) : (s >> 6);
                const f32x4 cs0 = *(const f32x4*)(tabm + pos * 16 + i0), cs1 = *(const f32x4*)(tabm + pos * 16 + i0 + 2);
                f32x4 r0, r1;
                r0[0] = v0[0] * cs0[0] - v0[1] * cs0[1]; r0[1] = v0[1] * cs0[0] + v0[0] * cs0[1];
                r0[2] = v0[2] * cs0[2] - v0[3] * cs0[3]; r0[3] = v0[3] * cs0[2] + v0[2] * cs0[3];
                r1[0] = v1[0] * cs1[0] - v1[1] * cs1[1]; r1[1] = v1[1] * cs1[0] + v1[0] * cs1[1];
                r1[2] = v1[2] * cs1[2] - v1[3] * cs1[3]; r1[3] = v1[3] * cs1[2] + v1[2] * cs1[3];
                v0 = r0; v1 = r1; }
            *(u32x4*)(dst + (size_t)row * 1536 + c) = pack8(v0, v1);
        EPI_END
    }
};
struct EpiGL {
    static constexpr bool PERM = true;
    bf16_t* dst; float scale;
    __device__ __forceinline__ void operator()(const f32x4 (&acc)[2][2][4][2], const Unit& u, int wr, int wc, int fr, int fq) const {
        EPI_BEGIN
#pragma unroll
            for (int e = 0; e < 4; ++e) { v0[e] = fast_sigmoid(v0[e] * scale); v1[e] = fast_sigmoid(v1[e] * scale); }
            u32x4 w_; w_.x = cvt_pk_bf16_safe(v0[0], v0[1]); w_.y = cvt_pk_bf16_safe(v0[2], v0[3]); w_.z = cvt_pk_bf16_safe(v1[0], v1[1]); w_.w = cvt_pk_bf16_safe(v1[2], v1[3]);
            *(u32x4*)(dst + (size_t)row * 6144 + u.pn * 256 + lc) = w_;
        EPI_END
    }
};
struct EpiBR {
    static constexpr bool PERM = true;
    const bf16_t* gl; bf16_t* merged; int first;
    __device__ __forceinline__ void operator()(const f32x4 (&acc)[2][2][4][2], const Unit& u, int wr, int wc, int fr, int fq) const {
        EPI_BEGIN
            const int c = u.pn * 256 + lc;
            const u32x4 gw = *(const u32x4*)(gl + (size_t)row * 6144 + c);
            bf16_t* mp = merged + (size_t)row * 2048 + c;
            f32x4 p0 = (f32x4){0.f, 0.f, 0.f, 0.f}, p1 = p0;
            if (!first) { const u32x4 pw = *(const u32x4*)mp; p0 = (f32x4){bf_lo(pw.x), bf_hi(pw.x), bf_lo(pw.y), bf_hi(pw.y)}; p1 = (f32x4){bf_lo(pw.z), bf_hi(pw.z), bf_lo(pw.w), bf_hi(pw.w)}; }
            v0[0] = p0[0] + v0[0] * bf_lo(gw.x); v0[1] = p0[1] + v0[1] * bf_hi(gw.x); v0[2] = p0[2] + v0[2] * bf_lo(gw.y); v0[3] = p0[3] + v0[3] * bf_hi(gw.y);
            v1[0] = p1[0] + v1[0] * bf_lo(gw.z); v1[1] = p1[1] + v1[1] * bf_hi(gw.z); v1[2] = p1[2] + v1[2] * bf_lo(gw.w); v1[3] = p1[3] + v1[3] * bf_hi(gw.w);
            *(u32x4*)mp = pack8(v0, v1);
        EPI_END
    }
};
struct EpiOut {
    static constexpr bool PERM = true;
    const float* xp; const float* xs; float* out; float* ssq;
    __device__ __forceinline__ void operator()(const f32x4 (&acc)[2][2][4][2], const Unit& u, int wr, int wc, int fr, int fq) const {
#pragma unroll
        for (int ai = 0; ai < 2; ++ai)
#pragma unroll
            for (int m = 0; m < 4; ++m) { const int row = u.pm * BM + ai * HALF + wr * 64 + m * 16 + fr;
                const float* xr = row < TP ? xp + (size_t)row * DM : xs + (size_t)(row - TP) * DM; float* orow = out + (size_t)row * DM; float sq = 0.f;
#pragma unroll
                for (int bj = 0; bj < 2; ++bj) { const int c = u.pn * 256 + bj * HALF + wc * 32 + 8 * fq;
                    f32x4 v0 = acc[ai][bj][m][0] * PROBE_BETA + *(const f32x4*)(xr + c), v1 = acc[ai][bj][m][1] * PROBE_BETA + *(const f32x4*)(xr + c + 4);
                    sq += (v0[0] * v0[0] + v0[1] * v0[1]) + (v0[2] * v0[2] + v0[3] * v0[3]) + (v1[0] * v1[0] + v1[1] * v1[1]) + (v1[2] * v1[2] + v1[3] * v1[3]);
                    *(f32x4*)(orow + c) = v0; *(f32x4*)(orow + c + 4) = v1; }
                (void)sq; }
    }
};
}

#ifndef ATT_SDX
#define ATT_SDX 1
#endif
#ifndef QKT_SBAR
#define QKT_SBAR SBAR()
#endif
namespace att {
constexpr int QBLK = 32, KVBLK = 64, NW = 8;
constexpr float THR = 8.f;
constexpr int SHM_V = KVBLK * 128 * 2, SHM_K = KVBLK * 128 * 2, SHM_KX = KVBLK * 144;
constexpr int OFF_V = 0, OFF_K = 2 * SHM_V, OFF_KX = OFF_K + 2 * SHM_K, OFF_WS = OFF_KX + 2 * SHM_KX, OFF_QX = OFF_WS + NW * 64 * 4, SHM_ATTN = OFF_QX + NW * 4 * 64 * 16;
static_assert(SHM_ATTN <= 131072, "attention LDS");
#define KSWZ(row, colB) ((row) * 256 + ((colB) ^ (((row) & 7) << 4)))
#define KXSWZ(row, cbi) ((row) * 144 + ((cbi) << 4))
#define SBAR() __builtin_amdgcn_sched_barrier(0)
__device__ __forceinline__ int crow(int r, int hi) { return (r & 3) + 8 * (r >> 2) + 4 * hi; }

template <int SC> __device__ __forceinline__ void partialSM(f32x16& p0, f32x16& p1, float& m_reg, float& mn, float& alpha) {
  constexpr float SCALE = SC == 192 ? 0.07216878364870323f : 0.08838834764831843f;
  constexpr float C = SCALE * 1.4426950408889634f;
  float pmax = p0[0];
#pragma unroll
  for (int r = 1; r < 16; ++r) pmax = fmaxf(pmax, p0[r]);
#pragma unroll
  for (int r = 0; r < 16; ++r) pmax = fmaxf(pmax, p1[r]);
  { auto rr = __builtin_amdgcn_permlane32_swap(__float_as_uint(pmax), __float_as_uint(pmax), false, false);
    pmax = fmaxf(__uint_as_float(rr[0]), __uint_as_float(rr[1])); }
  if (__builtin_expect(__all(pmax - m_reg <= THR / SCALE), 1)) { mn = m_reg; alpha = 1.f; }
  else { mn = fmaxf(m_reg, pmax); alpha = __builtin_amdgcn_exp2f((m_reg - mn) * C); m_reg = mn; }
  float mnC = -mn * C;
#pragma unroll
  for (int r = 0; r < 16; ++r) p0[r] = fmaf(p0[r], C, mnC);
#pragma unroll
  for (int r = 0; r < 16; ++r) p1[r] = fmaf(p1[r], C, mnC);
#pragma unroll
  for (int r = 0; r < 16; ++r) p0[r] = __builtin_amdgcn_exp2f(p0[r]);
}
__device__ __forceinline__ void finishSM(f32x16& p0, f32x16& p1, float alpha, float& l_reg, bf16x8& pa0, bf16x8& pa1, bf16x8& pa2, bf16x8& pa3) {
#pragma unroll
  for (int r = 0; r < 16; ++r) p1[r] = __builtin_amdgcn_exp2f(p1[r]);
  float ps = 0;
#pragma unroll
  for (int r = 0; r < 16; ++r) ps += p0[r];
#pragma unroll
  for (int r = 0; r < 16; ++r) ps += p1[r];
  { auto rr = __builtin_amdgcn_permlane32_swap(__float_as_uint(ps), __float_as_uint(ps), false, false);
    ps = __uint_as_float(rr[0]) + __uint_as_float(rr[1]); }
  l_reg = l_reg * alpha + ps;
  SBAR();
#define PK4(P, BASE, OUT) do { unsigned a0 = cvt_pk_bf16(P[BASE + 0], P[BASE + 1]), a1 = cvt_pk_bf16(P[BASE + 2], P[BASE + 3]);   \
    unsigned b0 = cvt_pk_bf16(P[BASE + 4], P[BASE + 5]), b1 = cvt_pk_bf16(P[BASE + 6], P[BASE + 7]);                              \
    auto r0 = __builtin_amdgcn_permlane32_swap(a0, b0, false, false); auto r1 = __builtin_amdgcn_permlane32_swap(a1, b1, false, false); \
    u32x4 w = {r0[0], r1[0], r0[1], r1[1]}; OUT = *reinterpret_cast<bf16x8*>(&w); } while (0)
  PK4(p0, 0, pa0); PK4(p0, 8, pa1); PK4(p1, 0, pa2); PK4(p1, 8, pa3);
#undef PK4
}
template <int DKX> __device__ __forceinline__ void qkt(f32x16& p0, f32x16& p1, const LAS char* Ks, const LAS char* Kxs, const bf16x8* qr, const LAS char* qx, int r32, int hi) {
  p0 = f32x16{}; p1 = f32x16{};
#pragma unroll
  for (int d0 = 0; d0 < 8; ++d0) { int cb = (d0 * 16 + hi * 8) * 2;
    bf16x8 b0 = *(const LAS bf16x8*)(Ks + KSWZ(r32, cb));
    bf16x8 b1 = *(const LAS bf16x8*)(Ks + KSWZ(32 + r32, cb));
    p0 = __builtin_amdgcn_mfma_f32_32x32x16_bf16(b0, qr[d0], p0, 0, 0, 0);
    p1 = __builtin_amdgcn_mfma_f32_32x32x16_bf16(b1, qr[d0], p1, 0, 0, 0); }
  if constexpr (DKX > 0) {
    int zz = 0; asm volatile("" : "+v"(zz)); qx += zz;
    const LAS char* kxp = Kxs + KXSWZ(r32, hi);
#pragma unroll
    for (int dx = 0; dx < DKX / 16; ++dx) {
      bf16x8 b0 = *(const LAS bf16x8*)(kxp + dx * 32);
      bf16x8 b1 = *(const LAS bf16x8*)(kxp + dx * 32 + 32 * 144);
      const bf16x8 qf = *(const LAS bf16x8*)(qx + dx * 1024);
      p0 = __builtin_amdgcn_mfma_f32_32x32x16_bf16(b0, qf, p0, 0, 0, 0);
      p1 = __builtin_amdgcn_mfma_f32_32x32x16_bf16(b1, qf, p1, 0, 0, 0); }
  }
}
__device__ __forceinline__ int v_st(int k, int c) { const int kk = (k & ~0xC) | ((k & 4) << 1) | ((k & 8) >> 1); return ((kk >> 3) * 4 + (c >> 5)) * 512 + ((kk & 7) * 32 + (c & 31)) * 2; }
__device__ __forceinline__ int v_rd_base(int lane) { return ((lane & 3) << 3) | (((lane >> 2) & 3) << 6) | (((lane >> 4) & 1) << 5) | (((lane >> 5) & 1) << 8); }
constexpr int v_rd_off(int d0, int ks, int half) { return d0 * 512 + ks * 4096 + half * 2048; }
template <int OFF> __device__ __forceinline__ s16x4 tr_read(int vb) {
  s16x4 r; asm volatile("ds_read_b64_tr_b16 %0, %1 offset:%2" : "=&v"(r) : "v"(vb), "i"(OFF) : "memory"); return r;
}
template <int D0> __device__ __forceinline__ void pv_one(f32x16& od, int vb, bf16x8 pa0, bf16x8 pa1, bf16x8 pa2, bf16x8 pa3) {
  const s16x4 l0 = tr_read<v_rd_off(D0, 0, 0)>(vb), h0 = tr_read<v_rd_off(D0, 0, 1)>(vb), l1 = tr_read<v_rd_off(D0, 1, 0)>(vb), h1 = tr_read<v_rd_off(D0, 1, 1)>(vb);
  const s16x4 l2 = tr_read<v_rd_off(D0, 2, 0)>(vb), h2 = tr_read<v_rd_off(D0, 2, 1)>(vb), l3 = tr_read<v_rd_off(D0, 3, 0)>(vb), h3 = tr_read<v_rd_off(D0, 3, 1)>(vb);
  asm volatile("s_waitcnt lgkmcnt(0)" ::: "memory"); SBAR();
#define PK(L, H) (bf16x8){L[0], L[1], L[2], L[3], H[0], H[1], H[2], H[3]}
  od = __builtin_amdgcn_mfma_f32_32x32x16_bf16(pa0, PK(l0, h0), od, 0, 0, 0);
  od = __builtin_amdgcn_mfma_f32_32x32x16_bf16(pa1, PK(l1, h1), od, 0, 0, 0);
  od = __builtin_amdgcn_mfma_f32_32x32x16_bf16(pa2, PK(l2, h2), od, 0, 0, 0);
  od = __builtin_amdgcn_mfma_f32_32x32x16_bf16(pa3, PK(l3, h3), od, 0, 0, 0);
#undef PK
}
__device__ __forceinline__ void pv_d0(f32x16* o, int vb, bf16x8 pa0, bf16x8 pa1, bf16x8 pa2, bf16x8 pa3) {
  pv_one<0>(o[0], vb, pa0, pa1, pa2, pa3); pv_one<1>(o[1], vb, pa0, pa1, pa2, pa3); pv_one<2>(o[2], vb, pa0, pa1, pa2, pa3); pv_one<3>(o[3], vb, pa0, pa1, pa2, pa3);
}

template <int DKX, int LDQ, int LDK, int LDV, int SC>
__device__ __forceinline__ void attn_unit(const bf16_t* __restrict__ Qb, const bf16_t* __restrict__ Kh, const bf16_t* __restrict__ Kx, const bf16_t* __restrict__ Vh,
                                          bf16_t* Zb, int seq, LAS char* lds) {
  constexpr int SDEPTH = (DKX > 0) ? ATT_SDX : 2; constexpr int NQ = 8; constexpr int LDO = 3072;
  int tid = threadIdx.x; asm volatile("" : "+v"(tid));
  const int wid = tid >> 6, lane = tid & 63, r32 = lane & 31, hi = lane >> 5;
  LAS char* V_lds = lds + OFF_V; LAS char* K_lds = lds + OFF_K; LAS char* KX_lds = lds + OFF_KX;
  LAS float* ws = (LAS float*)(lds + OFF_WS) + wid * 64; LAS float* li_l = ws; LAS float* al_l = ws + 32;
  float m_reg = -1e30f, l_reg = 0; f32x16 o[4] = {}; bf16x8 qr[NQ];
  const bf16_t* Qw = Qb + (long)(wid * QBLK + r32) * LDQ + hi * 8;
#pragma unroll
  for (int d0 = 0; d0 < NQ; ++d0) qr[d0] = *reinterpret_cast<const bf16x8*>(Qw + d0 * 16);
  LAS char* qx = lds + OFF_QX + (wid * 256 + lane) * 16;
  if constexpr (DKX > 0) {
#pragma unroll
    for (int dx = 0; dx < DKX / 16; ++dx) *(LAS bf16x8*)(qx + dx * 1024) = *reinterpret_cast<const bf16x8*>(Qw + 128 + dx * 16);
  }
  const int sr = tid >> 4, sc = (tid & 15) * 8, vst0 = v_st(sr, sc), vst1 = v_st(32 + sr, sc);
  const int xr = tid >> 3, xc = tid & 7, kxst = KXSWZ(xr, xc);
  const int vb0 = (int)(unsigned)(uintptr_t)V_lds + v_rd_base(lane);
  const unsigned vof0 = (unsigned)(sr * LDV + sc), vof1 = vof0 + 32u * LDV, kof0 = (unsigned)(sr * LDK + sc), kof1 = kof0 + 32u * LDK, xof = (unsigned)(xr * 64 + xc * 8);
  struct { bf16x8 vs0, vs1, ks0, ks1, kx; } sr_[SDEPTH];
#define SLOAD(i, k0) do { const bf16_t* Vt_ = Vh + (size_t)(k0) * LDV; const bf16_t* Kt_ = Kh + (size_t)(k0) * LDK; \
    sr_[i].vs0 = *reinterpret_cast<const bf16x8*>(Vt_ + vof0); sr_[i].vs1 = *reinterpret_cast<const bf16x8*>(Vt_ + vof1); \
    sr_[i].ks0 = *reinterpret_cast<const bf16x8*>(Kt_ + kof0); sr_[i].ks1 = *reinterpret_cast<const bf16x8*>(Kt_ + kof1); \
    if constexpr (DKX > 0) { const bf16_t* Xt_ = Kx + (size_t)(k0) * 64; sr_[i].kx = *reinterpret_cast<const bf16x8*>(Xt_ + xof); } } while (0)
#define SWRITE(b, i) do { *(LAS bf16x8*)(V_lds + (b) * SHM_V + vst0) = sr_[i].vs0;          \
    *(LAS bf16x8*)(V_lds + (b) * SHM_V + vst1) = sr_[i].vs1; int kc = sc * 2;               \
    *(LAS bf16x8*)(K_lds + (b) * SHM_K + KSWZ(sr, kc)) = sr_[i].ks0;                       \
    *(LAS bf16x8*)(K_lds + (b) * SHM_K + KSWZ(32 + sr, kc)) = sr_[i].ks1;                   \
    if constexpr (DKX > 0) *(LAS bf16x8*)(KX_lds + (b) * SHM_KX + kxst) = sr_[i].kx; } while (0)
#define SWAIT() do { if constexpr (SDEPTH == 1) asm volatile("s_waitcnt vmcnt(0)" ::: "memory"); else if constexpr (DKX > 0) asm volatile("s_waitcnt vmcnt(5)" ::: "memory"); else asm volatile("s_waitcnt vmcnt(4)" ::: "memory"); } while (0)
#define RESC(a) do { if (__any((a) < 1.f)) { if (hi == 0) al_l[r32] = (a); asm volatile("s_waitcnt lgkmcnt(0)" ::: "memory"); \
    _Pragma("unroll") for (int d = 0; d < 4; ++d) _Pragma("unroll") for (int r = 0; r < 16; ++r) o[d][r] *= al_l[crow(r, hi)]; } } while (0)
  f32x16 pA0, pA1, pB0, pB1; float mnA, mnB, alA, alB; bf16x8 pa0, pa1, pa2, pa3; const int NT = seq / KVBLK;
  constexpr int SE = 0, SO = SDEPTH - 1;
  SLOAD(SE, 0); asm volatile("s_waitcnt vmcnt(0)" ::: "memory"); SWRITE(0, SE); __syncthreads();
  qkt<DKX>(pA0, pA1, K_lds, KX_lds, qr, qx, r32, hi); partialSM<SC>(pA0, pA1, m_reg, mnA, alA);
  SLOAD(SO, KVBLK); if constexpr (SDEPTH == 2) { if (2 < NT) SLOAD(SE, 2 * KVBLK); }
  SWAIT(); SWRITE(1, SO); __syncthreads();
  for (int j = 1; j + 1 < NT; j += 2) {
    SBAR(); qkt<DKX>(pB0, pB1, K_lds + SHM_K, KX_lds + SHM_KX, qr, qx, r32, hi);
    finishSM(pA0, pA1, alA, l_reg, pa0, pa1, pa2, pa3); SBAR();
    SLOAD(SO, (j + SDEPTH) * KVBLK); SBAR();
    pv_d0(o, vb0, pa0, pa1, pa2, pa3); partialSM<SC>(pB0, pB1, m_reg, mnB, alB);
    __syncthreads(); SWAIT(); SWRITE(0, SE);
    RESC(alB); __syncthreads();
    SBAR(); qkt<DKX>(pA0, pA1, K_lds, KX_lds, qr, qx, r32, hi);
    finishSM(pB0, pB1, alB, l_reg, pa0, pa1, pa2, pa3); SBAR();
    if (SDEPTH == 1 || j + 3 < NT) SLOAD(SE, (j + 1 + SDEPTH) * KVBLK); SBAR();
    pv_d0(o, vb0 + (int)SHM_V, pa0, pa1, pa2, pa3); partialSM<SC>(pA0, pA1, m_reg, mnA, alA);
    __syncthreads(); SWAIT(); SWRITE(1, SO);
    RESC(alA); __syncthreads();
  }
  SBAR(); qkt<DKX>(pB0, pB1, K_lds + SHM_K, KX_lds + SHM_KX, qr, qx, r32, hi);
  finishSM(pA0, pA1, alA, l_reg, pa0, pa1, pa2, pa3); SBAR();
  pv_d0(o, vb0, pa0, pa1, pa2, pa3); partialSM<SC>(pB0, pB1, m_reg, mnB, alB);
  __syncthreads(); RESC(alB);
  finishSM(pB0, pB1, alB, l_reg, pa0, pa1, pa2, pa3); SBAR();
  pv_d0(o, vb0 + (int)SHM_V, pa0, pa1, pa2, pa3);
  if (hi == 0) li_l[r32] = l_reg; asm volatile("s_waitcnt lgkmcnt(0)" ::: "memory");
#pragma unroll
  for (int r = 0; r < 16; ++r) { const float rl_ = __builtin_amdgcn_rcpf(li_l[crow(r, hi)]);
#pragma unroll
    for (int d0 = 0; d0 < 4; ++d0) o[d0][r] *= rl_; }
  bf16_t* Zw = Zb + (long)(wid * QBLK) * LDO + r32;
#pragma unroll
  for (int d0 = 0; d0 < 4; ++d0)
#pragma unroll
    for (int rh = 0; rh < 2; ++rh) { bf16_t zv[8];
#pragma unroll
      for (int r = 0; r < 8; ++r) zv[r] = Zw[(long)crow(rh * 8 + r, hi) * LDO + d0 * 32];
#pragma unroll
      for (int r = 0; r < 8; ++r) Zw[(long)crow(rh * 8 + r, hi) * LDO + d0 * 32] = (bf16_t)(cvt_pk_bf16(o[d0][rh * 8 + r] * __uint_as_float((unsigned)zv[r] << 16), 0.f) & 0xffffu); }
#undef SLOAD
#undef SWRITE
#undef SWAIT
#undef RESC
}
}

__device__ __forceinline__ void mem_attn_wave(const bf16_t* __restrict__ QM, const bf16_t* __restrict__ KM, const bf16_t* __restrict__ VMT, bf16_t* Z, int b, int h, int rg, int lane) {
    const int jr = lane & 15, q = lane >> 4;
    const size_t row = (size_t)b * SEQ + rg * 16 + jr;
    bf16x8 qf[8];
#pragma unroll
    for (int c = 0; c < 8; ++c) qf[c] = *(const bf16x8*)(QM + row * 1024 + h * 256 + 32 * c + 8 * q);
    f32x4 S[16];
    const bf16_t* kb = KM + ((size_t)b * 256 + jr) * 1024 + h * 256 + 8 * q;
#pragma unroll
    for (int n = 0; n < 16; ++n) { f32x4 acc = (f32x4){0.f, 0.f, 0.f, 0.f};
#pragma unroll
        for (int c = 0; c < 8; ++c) { const bf16x8 kf = *(const bf16x8*)(kb + (size_t)n * 16 * 1024 + 32 * c); acc = __builtin_amdgcn_mfma_f32_16x16x32_bf16(kf, qf[c], acc, 0, 0, 0); }
        S[n] = acc; }
    float m = -1e30f;
#pragma unroll
    for (int n = 0; n < 16; ++n) m = fmaxf(fmaxf(fmaxf(S[n][0], S[n][1]), fmaxf(S[n][2], S[n][3])), m);
    m = fmaxf(m, __shfl_xor(m, 16)); m = fmaxf(m, __shfl_xor(m, 32));
    constexpr float C = 0.0625f * 1.4426950408889634f; const float mC = -m * C; float l = 0.f;
#pragma unroll
    for (int n = 0; n < 16; ++n)
#pragma unroll
        for (int e = 0; e < 4; ++e) { const float p = __builtin_amdgcn_exp2f(fmaf(S[n][e], C, mC)); S[n][e] = p; l += p; }
    l += __shfl_xor(l, 16); l += __shfl_xor(l, 32);
    const float rl = __builtin_amdgcn_rcpf(l);
    __builtin_amdgcn_sched_barrier(0);
    bf16x8 pf[8];
#pragma unroll
    for (int c = 0; c < 8; ++c) { u32x4 w; w.x = cvt_pk_bf16(S[2 * c][0], S[2 * c][1]); w.y = cvt_pk_bf16(S[2 * c][2], S[2 * c][3]); w.z = cvt_pk_bf16(S[2 * c + 1][0], S[2 * c + 1][1]); w.w = cvt_pk_bf16(S[2 * c + 1][2], S[2 * c + 1][3]);
        pf[c] = *reinterpret_cast<bf16x8*>(&w); }
    const bf16_t* vb = VMT + ((size_t)h * 256 + jr) * MEMROWS + b * 256 + 8 * q;
    bf16_t* zrow = Z + row * 3072 + 2048 + h * 256 + 4 * q;
    u32x2 zz[16];
#pragma unroll
    for (int n = 0; n < 16; ++n) zz[n] = *(const u32x2*)(zrow + 16 * n);
#pragma unroll
    for (int n = 0; n < 16; ++n) { f32x4 acc = (f32x4){0.f, 0.f, 0.f, 0.f};
#pragma unroll
        for (int c = 0; c < 8; ++c) { const bf16x8 vf = *(const bf16x8*)(vb + (size_t)n * 16 * MEMROWS + 32 * c); acc = __builtin_amdgcn_mfma_f32_16x16x32_bf16(vf, pf[c], acc, 0, 0, 0); }
        u32x2 w; w.x = cvt_pk_bf16(acc[0] * rl * bf_lo(zz[n].x), acc[1] * rl * bf_hi(zz[n].x)); w.y = cvt_pk_bf16(acc[2] * rl * bf_lo(zz[n].y), acc[3] * rl * bf_hi(zz[n].y));
        *(u32x2*)(zrow + 16 * n) = w; }
}


__device__ __forceinline__ void mem_attn_block(const bf16_t* __restrict__ QM, const bf16_t* __restrict__ KM, const bf16_t* __restrict__ VMT, bf16_t* Z, int b, int h, int rb, LAS unsigned char* lds, int tid_in) {
    int tid = tid_in; asm volatile("" : "+v"(tid));
    const int wave = tid >> 6, lane = tid & 63, jr = lane & 15, q = lane >> 4;
    const size_t row = (size_t)b * SEQ + rb * 128 + wave * 16 + jr;
    {
        u32x4 st[16];
#pragma unroll
        for (int i = 0; i < 16; ++i) { const int g = tid + 512 * i, r_ = g >> 5, ch = g & 31; st[i] = *(const u32x4*)(KM + ((size_t)b * 256 + r_) * 1024 + h * 256 + ch * 8); }
#pragma unroll
        for (int i = 0; i < 16; ++i) { const int g = tid + 512 * i, r_ = g >> 5, ch = g & 31; *(LAS u32x4*)(lds + r_ * 512 + ((ch ^ (r_ & 15)) << 4)) = st[i]; }
    }
    bf16x8 qf[8];
#pragma unroll
    for (int c = 0; c < 8; ++c) qf[c] = *(const bf16x8*)(QM + row * 1024 + h * 256 + 32 * c + 8 * q);
    __syncthreads();
    f32x4 S[16];
#pragma unroll
    for (int n = 0; n < 16; ++n) { f32x4 acc = (f32x4){0.f, 0.f, 0.f, 0.f};
#pragma unroll
        for (int c = 0; c < 8; ++c) { const bf16x8 kf = *(const LAS bf16x8*)(lds + (16 * n + jr) * 512 + (((4 * c + q) ^ jr) << 4)); acc = __builtin_amdgcn_mfma_f32_16x16x32_bf16(kf, qf[c], acc, 0, 0, 0); }
        S[n] = acc; __builtin_amdgcn_sched_barrier(0); }
    float m = -1e30f;
#pragma unroll
    for (int n = 0; n < 16; ++n) m = fmaxf(fmaxf(fmaxf(S[n][0], S[n][1]), fmaxf(S[n][2], S[n][3])), m);
    m = fmaxf(m, __shfl_xor(m, 16)); m = fmaxf(m, __shfl_xor(m, 32));
    constexpr float C = 0.0625f * 1.4426950408889634f; const float mC = -m * C; float l = 0.f;
#pragma unroll
    for (int n = 0; n < 16; ++n)
#pragma unroll
        for (int e = 0; e < 4; ++e) { const float p = __builtin_amdgcn_exp2f(fmaf(S[n][e], C, mC)); S[n][e] = p; l += p; }
    l += __shfl_xor(l, 16); l += __shfl_xor(l, 32);
    const float rl = __builtin_amdgcn_rcpf(l);
    __builtin_amdgcn_sched_barrier(0);
    bf16x8 pf[8];
#pragma unroll
    for (int c = 0; c < 8; ++c) { u32x4 w; w.x = cvt_pk_bf16(S[2 * c][0], S[2 * c][1]); w.y = cvt_pk_bf16(S[2 * c][2], S[2 * c][3]); w.z = cvt_pk_bf16(S[2 * c + 1][0], S[2 * c + 1][1]); w.w = cvt_pk_bf16(S[2 * c + 1][2], S[2 * c + 1][3]);
        pf[c] = *reinterpret_cast<bf16x8*>(&w); }
    bf16_t* zrow = Z + row * 3072 + 2048 + h * 256 + 4 * q;
    u32x2 zz[16];
#pragma unroll
    for (int n = 0; n < 16; ++n) zz[n] = *(const u32x2*)(zrow + 16 * n);
    __syncthreads();
    {
        u32x4 st[16];
#pragma unroll
        for (int i = 0; i < 16; ++i) { const int g = tid + 512 * i, r_ = g >> 5, ch = g & 31; st[i] = *(const u32x4*)(VMT + ((size_t)h * 256 + r_) * MEMROWS + b * 256 + ch * 8); }
#pragma unroll
        for (int i = 0; i < 16; ++i) { const int g = tid + 512 * i, r_ = g >> 5, ch = g & 31; *(LAS u32x4*)(lds + r_ * 512 + ((ch ^ (r_ & 15)) << 4)) = st[i]; }
    }
    __syncthreads();
#pragma unroll
    for (int n = 0; n < 16; ++n) { f32x4 acc = (f32x4){0.f, 0.f, 0.f, 0.f};
#pragma unroll
        for (int c = 0; c < 8; ++c) { const bf16x8 vf = *(const LAS bf16x8*)(lds + (16 * n + jr) * 512 + (((4 * c + q) ^ jr) << 4)); acc = __builtin_amdgcn_mfma_f32_16x16x32_bf16(vf, pf[c], acc, 0, 0, 0); }
        u32x2 w; w.x = cvt_pk_bf16(acc[0] * rl * bf_lo(zz[n].x), acc[1] * rl * bf_hi(zz[n].x)); w.y = cvt_pk_bf16(acc[2] * rl * bf_lo(zz[n].y), acc[3] * rl * bf_hi(zz[n].y));
        *(u32x2*)(zrow + 16 * n) = w; __builtin_amdgcn_sched_barrier(0); }
    __syncthreads();
}

__device__ __forceinline__ int gperm_inv128(int p) { const int a = p >> 6, t = p & 63; return 64 * a + 32 * (t & 1) + (t >> 1); }
__device__ __forceinline__ int gperm_inv64(int p) { const int a = p >> 5, t = p & 31; return 32 * a + 16 * (t & 1) + (t >> 1); }
__device__ __forceinline__ int colmap(int kind, int n) {
    if (kind == 0) {
        if (n < 768) return n;
        if (n < 1024) { const int j = n - 768; return j < 64 ? 768 + gperm_inv64(j) : -1; }
        if (n < 2048) { const int j = n - 1024; return 832 + (j & ~127) + gperm_inv128(j & 127); }
        if (n < 2304) { const int j = n - 2048; return 1856 + (j & ~127) + gperm_inv128(j & 127); }
        return n - 2304 + 2112;
    }
    if (kind == 1) return 6464 + n;
    if (kind == 2) { const int h = n / 192, d = n % 192; return h * 192 + (d < 128 ? d : 128 + gperm_inv64(d - 128)); }
    if (kind == 3) { if (n < 1024) return (n >> 7) * 256 + (n & 127); const int m = n - 1024; return (m >> 7) * 256 + 128 + (m & 127); }
    return n;
}
__device__ __forceinline__ void transpose_item(const float* __restrict__ W, int ldw, int K, bf16_t* WT, int kind, int item, LAS unsigned char* scr, int tid) {
    const int nkb = K >> 6; const int nb = item / nkb, kb = item - nb * nkb; const int n0 = nb * 64, k0 = kb * 64;
    const int nl = tid & 63, kg = tid >> 6;
    const int col = colmap(kind, n0 + nl);
    float v[8];
#pragma unroll
    for (int j = 0; j < 8; ++j) v[j] = col >= 0 ? W[(size_t)(k0 + 8 * kg + j) * ldw + col] : 0.f;
    u32x4 o; o.x = cvt_pk_bf16(v[0], v[1]); o.y = cvt_pk_bf16(v[2], v[3]); o.z = cvt_pk_bf16(v[4], v[5]); o.w = cvt_pk_bf16(v[6], v[7]);
    *(LAS u32x4*)(scr + nl * 144 + kg * 16) = o;
    __syncthreads();
    const int row = tid >> 3, ch = tid & 7;
    const u32x4 w = *(const LAS u32x4*)(scr + row * 144 + ch * 16);
    *(u32x4*)(WT + (size_t)(n0 + row) * K + k0 + 8 * ch) = w;
    __syncthreads();
}

__device__ __forceinline__ unsigned pk4_fp8(float a, float b, float c, float d) { int w = __builtin_amdgcn_cvt_pk_fp8_f32(a, b, 0, false); w = __builtin_amdgcn_cvt_pk_fp8_f32(c, d, w, true); return (unsigned)w; }
__device__ __forceinline__ void transpose_item_fp8(const float* __restrict__ W, int ldw, int K, unsigned char* WT, int col0, int item, LAS unsigned char* scr, int tid) {
    const int nkb = K >> 6; const int nb = item / nkb, kb = item - nb * nkb; const int n0 = nb * 64, k0 = kb * 64;
    const int nl = tid & 63, kg = tid >> 6;
    float v[8];
#pragma unroll
    for (int j = 0; j < 8; ++j) v[j] = W8_SCALE * W[(size_t)(k0 + 8 * kg + j) * ldw + col0 + n0 + nl];
    u32x2 o; o.x = pk4_fp8(v[0], v[1], v[2], v[3]); o.y = pk4_fp8(v[4], v[5], v[6], v[7]);
    *(LAS u32x2*)(scr + nl * 72 + kg * 8) = o;
    __syncthreads();
    const int row = tid >> 3, ch = tid & 7;
    const u32x2 w = *(const LAS u32x2*)(scr + row * 72 + ch * 8);
    *(u32x2*)(WT + (size_t)(n0 + row) * K + k0 + 8 * ch) = w;
    __syncthreads();
}
__device__ __forceinline__ void rms_row_to_bf16(const float* __restrict__ xrow, const float* __restrict__ g, bf16_t* orow, unsigned char* o8row, int lane) {
    f32x4 v[8]; float s = 0.f;
#pragma unroll
    for (int j = 0; j < 8; ++j) { v[j] = ((const f32x4*)xrow)[lane + 64 * j]; s += (v[j][0] * v[j][0] + v[j][1] * v[j][1]) + (v[j][2] * v[j][2] + v[j][3] * v[j][3]); }
    const float rstd = 1.0f / sqrtf(wave_sum(s) * (1.f / DM) + EPS);
#pragma unroll
    for (int j = 0; j < 8; ++j) { const f32x4 gg = ((const f32x4*)g)[lane + 64 * j]; u32x2 w; w.x = cvt_pk_bf16(v[j][0] * rstd * gg[0], v[j][1] * rstd * gg[1]); w.y = cvt_pk_bf16(v[j][2] * rstd * gg[2], v[j][3] * rstd * gg[3]);
        ((u32x2*)orow)[lane + 64 * j] = w;
        if (o8row) ((unsigned*)o8row)[lane + 64 * j] = pk4_fp8(H8_SCALE * v[j][0] * rstd * gg[0], H8_SCALE * v[j][1] * rstd * gg[1], H8_SCALE * v[j][2] * rstd * gg[2], H8_SCALE * v[j][3] * rstd * gg[3]); }
}
__device__ __forceinline__ void sincos_d(float angf, float& c, float& s) {
    const double a = (double)angf; const double kq = rint(a * 0.63661977236758134308); const double r = a - kq * 1.57079632679489661923; const int qd = ((int)kq) & 3;
    const double r2 = r * r;
    const double sp = r * (1.0 + r2 * (-1.0 / 6 + r2 * (1.0 / 120 + r2 * (-1.0 / 5040 + r2 * (1.0 / 362880 + r2 * (-1.0 / 39916800 + r2 * (1.0 / 6227020800.0)))))));
    const double cp = 1.0 + r2 * (-0.5 + r2 * (1.0 / 24 + r2 * (-1.0 / 720 + r2 * (1.0 / 40320 + r2 * (-1.0 / 3628800 + r2 * (1.0 / 479001600 + r2 * (-1.0 / 87178291200.0)))))));
    double sv, cv;
    if (qd == 0) { sv = sp; cv = cp; } else if (qd == 1) { sv = cp; cv = -sp; } else if (qd == 2) { sv = -sp; cv = -cp; } else { sv = -cp; cv = sp; }
    c = (float)cv; s = (float)sv;
}

__device__ __forceinline__ void grid_barrier(unsigned* ctr, unsigned target) {
    __syncthreads();
    if (threadIdx.x == 0) {
        __builtin_amdgcn_fence(__ATOMIC_RELEASE, "agent");
        __hip_atomic_fetch_add(ctr, 1u, __ATOMIC_RELAXED, __HIP_MEMORY_SCOPE_AGENT);
        while (__hip_atomic_load(ctr, __ATOMIC_RELAXED, __HIP_MEMORY_SCOPE_AGENT) < target) __builtin_amdgcn_s_sleep(4);
    }
    __syncthreads();
    __builtin_amdgcn_fence(__ATOMIC_ACQUIRE, "agent");
}
struct Args { const float* in[17]; float* out; unsigned char* ws; int ph_lo, ph_hi; };
constexpr int NPHASE = 9;

template <bool COOP>
__global__ void __launch_bounds__(512) mk_fwd(Args args) {
    extern __shared__ __attribute__((aligned(16))) unsigned char lds_raw[];
    LAS unsigned char* lds = (LAS unsigned char*)lds_raw;
    const int tid = threadIdx.x, lane = tid & 63, wave = __builtin_amdgcn_readfirstlane(tid >> 6);
    const int G = gridDim.x, bid = blockIdx.x;
    const int gw = bid * 8 + wave, NGW = G * 8;
    unsigned char* ws = args.ws; unsigned char* dob = (unsigned char*)args.out;
    const float* xp = args.in[0]; const float* xs = args.in[1];
    bf16_t* H = (bf16_t*)(dob + DO_H); bf16_t* QMLA = (bf16_t*)(dob + DO_QMLA); bf16_t* MN = (bf16_t*)(dob + DO_MN);
    f32x2* TABG = (f32x2*)(ws + WS_TABG); f32x2* TABM = (f32x2*)(ws + WS_TABM); float* GQP = (float*)(ws + WS_GQP); float* GKP = (float*)(ws + WS_GKP);
    const int lo = args.ph_lo, hi = args.ph_hi;
    __builtin_amdgcn_fence(__ATOMIC_ACQUIRE, "agent");
#ifndef ONLY
#define ONLY -1
#endif
#define IN(k) ((ONLY < 0 || ONLY == (k)) && lo <= (k) && (k) < hi)
    unsigned nbar = 0;
#define SEAM(k) do { if constexpr (COOP) { if (IN(k) && IN((k) + 1)) { ++nbar; grid_barrier((unsigned*)(ws + WS_BAR), nbar * (unsigned)G); } } } while (0)

    if (IN(0)) {
        constexpr int I0 = (NP1 / 64) * 32, I1 = 96 * 32, I2 = 24 * 8, I3 = 32 * 4, I4 = 32 * 32, I5 = 32 * 16, I6 = 32 * 32;
        constexpr int NITEMS = I0 + I1 + I2 + I3 + I4 + 3 * I5 + I6;
        for (int it = bid; it < NITEMS; it += G) {
            int r = it;
            if (r < I0) { transpose_item(args.in[5], 12608, 2048, (bf16_t*)(ws + WS_WIN), 0, r, lds, tid); continue; } r -= I0;
            if (r < I1) { transpose_item_fp8(args.in[5], 12608, 2048, ws + WS_WGL, 6464, r, lds, tid); continue; } r -= I1;
            if (r < I2) { transpose_item(args.in[7], 1536, 512, (bf16_t*)(ws + WS_WQB), 2, r, lds, tid); continue; } r -= I2;
            if (r < I3) { transpose_item(args.in[9], 2048, 256, (bf16_t*)(ws + WS_WKVB), 3, r, lds, tid); continue; } r -= I3;
            if (r < I4) { transpose_item(args.in[13], 2048, 2048, (bf16_t*)(ws + WS_WMKV), 4, r, lds, tid); continue; } r -= I4;
            if (r < 3 * I5) { const int i = r / I5; transpose_item(args.in[14] + (size_t)i * 1024 * 2048, 2048, 1024, (bf16_t*)(ws + WS_WBR) + (size_t)i * 2048 * 1024, 4, r - i * I5, lds, tid); continue; } r -= 3 * I5;
            transpose_item(args.in[15], 2048, 2048, (bf16_t*)(ws + WS_WOUT), 4, r, lds, tid);
        }
        for (int m = gw; m < T + MEMROWS; m += NGW) {
            if (m < T) { const float* xr = m < TP ? xp + (size_t)m * DM : xs + (size_t)(m - TP) * DM; rms_row_to_bf16(xr, args.in[4], H + (size_t)m * DM, ws + WS_H8 + (size_t)m * DM, lane); }
            else { const int mm = m - T; const float* xr = mm < 2048 ? args.in[2] + (size_t)mm * DM : args.in[3] + (size_t)(mm - 2048) * DM; rms_row_to_bf16(xr, args.in[12], MN + (size_t)mm * DM, nullptr, lane); }
        }
        for (int e = bid * 512 + tid; e < 4096 * 64 * 2 / 16; e += G * 512) ((u32x4*)(ws + WS_ZERO))[e] = (u32x4){0u, 0u, 0u, 0u};
        if (bid == 0) {
            for (int e = tid; e < 64 * 32; e += 512) { const int pos = e >> 5, i = e & 31; double f = 1.0; for (int k = 0; k < i; ++k) f *= 0.7498942093324559; const float ang = (float)pos * (float)f; float c, s; sincos_d(ang, c, s); TABG[e] = (f32x2){c, s}; }
            for (int e = tid; e < 64 * 16; e += 512) { const int pos = e >> 4, i = e & 15; double f = 1.0; for (int k = 0; k < i; ++k) f *= 0.5623413251903491; const float ang = (float)pos * (float)f; float c, s; sincos_d(ang, c, s); TABM[e] = (f32x2){c, s}; }
            if (tid < 128) { GQP[tid] = args.in[10][gperm_inv128(tid)]; GKP[tid] = args.in[11][gperm_inv128(tid)]; }
        }
    }
    if constexpr (COOP) { if (IN(0) && IN(1)) cg::this_grid().sync(); }

    if (IN(1)) {
        { pg8::Gemm g{H, (const bf16_t*)(ws + WS_WIN), 2048, 2048, T, NP1, 2048}; pg8::StaticOrder S; S.init(T, NP1, G, bid);
          pg8::EpiP1 E{ws}; pg8::gemm_phase(lds, g, S, E); }
        { pg8::Gemm g{MN, (const bf16_t*)(ws + WS_WMKV), 2048, 2048, MEMROWS, 2048, 2048}; pg8::StaticOrder S; S.init(MEMROWS, 2048, G, (bid + 128) % G);
          pg8::EpiSplit E{(bf16_t*)(ws + WS_KM), (bf16_t*)(ws + WS_VM), 1024}; pg8::gemm_phase(lds, g, S, E); }
    }
    SEAM(1);

    if (IN(2)) {
        bf16_t* CQ = (bf16_t*)(ws + WS_CQ); bf16_t* CKV = (bf16_t*)(ws + WS_CKV); bf16_t* KPE = (bf16_t*)(ws + WS_KPE); bf16_t* QG = (bf16_t*)(ws + WS_QG); bf16_t* KG = (bf16_t*)(ws + WS_KG);
        const float* gq = args.in[6]; const float* gkv = args.in[8];
        const int ga_ = lane >> 5, gi_ = lane & 31; const float gq1 = GQP[2 * lane], gq2 = GQP[2 * lane + 1], gk1 = GKP[2 * lane], gk2 = GKP[2 * lane + 1];
        const f32x4 g0q = *(const f32x4*)(gq + lane * 8), g1q = *(const f32x4*)(gq + lane * 8 + 4), g0k = *(const f32x4*)(gkv + lane * 4);
        for (int r = gw; r < T; r += NGW) {
            const int s = r & 4095, prow = s >> 6, pcol = s & 63;
            bf16_t* pq = CQ + (size_t)r * 512 + lane * 8; bf16_t* pk = CKV + (size_t)r * 256 + lane * 4; unsigned* pe = (unsigned*)(KPE + (size_t)r * 64) + (lane & 31);
            const u32x4 wq = *(const u32x4*)pq; const u32x2 wk = *(const u32x2*)pk; const unsigned we = *pe;
            unsigned wh[10];
#pragma unroll
            for (int h = 0; h < 10; ++h) wh[h] = *((h < 8 ? (const unsigned*)(QG + (size_t)r * 1024 + h * 128) : (const unsigned*)(KG + (size_t)r * 256 + (h - 8) * 128)) + lane);
            const f32x2 csm = TABM[(((lane >> 4) & 1) ? pcol : prow) * 16 + (lane & 15)]; const f32x2 cs = TABG[(ga_ ? pcol : prow) * 32 + gi_];
            { float x[8] = {bf_lo(wq.x), bf_hi(wq.x), bf_lo(wq.y), bf_hi(wq.y), bf_lo(wq.z), bf_hi(wq.z), bf_lo(wq.w), bf_hi(wq.w)};
              float ss = 0.f;
#pragma unroll
              for (int j = 0; j < 8; ++j) ss += x[j] * x[j];
              const float rstd = 1.0f / sqrtf(wave_sum(ss) * (1.f / 512) + EPS);
              u32x4 o; o.x = cvt_pk_bf16(x[0] * rstd * g0q[0], x[1] * rstd * g0q[1]); o.y = cvt_pk_bf16(x[2] * rstd * g0q[2], x[3] * rstd * g0q[3]); o.z = cvt_pk_bf16(x[4] * rstd * g1q[0], x[5] * rstd * g1q[1]); o.w = cvt_pk_bf16(x[6] * rstd * g1q[2], x[7] * rstd * g1q[3]);
              *(u32x4*)pq = o; }
            { float x[4] = {bf_lo(wk.x), bf_hi(wk.x), bf_lo(wk.y), bf_hi(wk.y)};
              const float ss = (x[0] * x[0] + x[1] * x[1]) + (x[2] * x[2] + x[3] * x[3]);
              const float rstd = 1.0f / sqrtf(wave_sum(ss) * (1.f / 256) + EPS);
              u32x2 o; o.x = cvt_pk_bf16(x[0] * rstd * g0k[0], x[1] * rstd * g0k[1]); o.y = cvt_pk_bf16(x[2] * rstd * g0k[2], x[3] * rstd * g0k[3]); *(u32x2*)pk = o; }
            if (lane < 32) { const float x1 = bf_lo(we), x2 = bf_hi(we); *pe = cvt_pk_bf16(x1 * csm[0] - x2 * csm[1], x2 * csm[0] + x1 * csm[1]); }
#pragma unroll
            for (int h = 0; h < 10; ++h) { float x1 = bf_lo(wh[h]), x2 = bf_hi(wh[h]); const float rstd = 1.0f / sqrtf(wave_sum(x1 * x1 + x2 * x2) * (1.f / 128) + EPS);
                x1 = x1 * rstd * (h < 8 ? gq1 : gk1); x2 = x2 * rstd * (h < 8 ? gq2 : gk2);
                *((h < 8 ? (unsigned*)(QG + (size_t)r * 1024 + h * 128) : (unsigned*)(KG + (size_t)r * 256 + (h - 8) * 128)) + lane) = cvt_pk_bf16(x1 * cs[0] - x2 * cs[1], x2 * cs[0] + x1 * cs[1]); }
        }
        const bf16_t* VM = (const bf16_t*)(ws + WS_VM); bf16_t* VMT = (bf16_t*)(ws + WS_VMT);
        for (int ln = gw; ln < 1024 * NBATCH * 4; ln += NGW) { const int c = ln / (NBATCH * 4), rem = ln - c * (NBATCH * 4); const int b = rem >> 2, seg = rem & 3;
            const int pos = seg * 64 + lane; const int key = (pos & ~31) + 16 * ((pos >> 2) & 1) + 4 * ((pos >> 3) & 3) + (pos & 3);
            VMT[(size_t)c * MEMROWS + b * 256 + pos] = VM[(size_t)(b * 256 + key) * 1024 + c]; }
    }
    SEAM(2);


    if (IN(3)) {
        { pg8::Gemm g{(const bf16_t*)(ws + WS_CQ), (const bf16_t*)(ws + WS_WQB), 512, 512, T, 1536, 512}; pg8::StaticOrder S; S.init(T, 1536, G, bid);
          pg8::EpiQ E{QMLA, TABM}; pg8::gemm_phase(lds, g, S, E); }
        { pg8::Gemm g{(const bf16_t*)(ws + WS_CKV), (const bf16_t*)(ws + WS_WKVB), 256, 256, T, 2048, 256}; pg8::StaticOrder S; S.init(T, 2048, G, bid);
          pg8::EpiSplit E{(bf16_t*)(ws + WS_KN), (bf16_t*)(ws + WS_VN), 1024}; pg8::gemm_phase(lds, g, S, E); }
    }
    SEAM(3);


    if (IN(4)) {
        bf16_t* Z = (bf16_t*)(ws + WS_Z);
        const int NU = NBATCH * 8 * 16;
#define DECODE_UNIT(u) int bh, qb; if (G == 256) { const int i_ = (u) >> 8, c_ = (u) & 255; qb = (c_ >> 3) & 15; bh = i_ * 16 + (c_ & 7) * 2 + (c_ >> 7); } else { bh = (u) >> 4; qb = (u) & 15; } \
        const int b = bh >> 3, h = bh & 7; const size_t r0 = (size_t)b * SEQ + qb * 256;
#ifndef SKIP_MLA
        for (int u = bid; u < NU; u += G) { DECODE_UNIT(u)
            att::attn_unit<64, 1536, 1024, 1024, 192>(QMLA + r0 * 1536 + h * 192, (const bf16_t*)(ws + WS_KN) + (size_t)b * SEQ * 1024 + h * 128, (const bf16_t*)(ws + WS_KPE) + (size_t)b * SEQ * 64,
                                                  (const bf16_t*)(ws + WS_VN) + (size_t)b * SEQ * 1024 + h * 128, Z + r0 * 3072 + h * 128, SEQ, (LAS char*)lds); }
#endif
#ifndef SKIP_GQA
        for (int u = bid; u < NU; u += G) { DECODE_UNIT(u)
            att::attn_unit<0, 1024, 256, 256, 128>((const bf16_t*)(ws + WS_QG) + r0 * 1024 + h * 128, (const bf16_t*)(ws + WS_KG) + (size_t)b * SEQ * 256 + (h >> 2) * 128, nullptr,
                                               (const bf16_t*)(ws + WS_VG) + (size_t)b * SEQ * 256 + (h >> 2) * 128, Z + r0 * 3072 + 1024 + h * 128, SEQ, (LAS char*)lds); }
#endif
#undef DECODE_UNIT
#ifndef SKIP_MEM
        for (int u = bid; u < NBATCH * 4 * 32; u += G) { const int bh = u >> 5, rb = u & 31;
            mem_attn_block((const bf16_t*)(ws + WS_QM), (const bf16_t*)(ws + WS_KM), (const bf16_t*)(ws + WS_VMT), Z, bh >> 2, bh & 3, rb, lds, tid); }
#endif
    }
    SEAM(4);


#ifdef PROBE_CHECK
    if (lo == 20) {
        unsigned* cnt = (unsigned*)(ws + WS_ZERO + 4096 * 64 * 2 - 32);
        { const unsigned sidx = (unsigned)(bid * 512 + tid); const int tok = (int)((sidx * 2654435761u >> 7) % 2560u), c = (int)((sidx * 40503u >> 2) & 1023u); const int b_ = tok >> 8, key = tok & 255; const int pos = (key & ~31) + 8 * ((key >> 2) & 3) + 4 * ((key >> 4) & 1) + (key & 3);
          const bf16_t a_ = ((const bf16_t*)(ws + WS_VMT))[(size_t)c * MEMROWS + b_ * 256 + pos], b2_ = ((const bf16_t*)(ws + WS_VM))[(size_t)tok * 1024 + c]; if (a_ != b2_) atomicAdd(cnt + ((c & 128) ? 2 : 3), 1u); }
        const int w = bid * 8 + wave; const int r = (int)(((long)w * 977 + 13) % T); const int b = r >> 12; const int br = PROBE_BR;
        const int h = w & (br == 2 ? 3 : 7);
        const bf16_t* Qp; const bf16_t* Kp; const bf16_t* Xp = nullptr; const bf16_t* Vp; int ldk, ldv, dk, nk; float scale;
        if (br == 0) { Qp = QMLA + (size_t)r * 1536 + h * 192; Kp = (const bf16_t*)(ws + WS_KN) + (size_t)b * SEQ * 1024 + h * 128; Xp = (const bf16_t*)(ws + WS_KPE) + (size_t)b * SEQ * 64; Vp = (const bf16_t*)(ws + WS_VN) + (size_t)b * SEQ * 1024 + h * 128; ldk = 1024; ldv = 1024; dk = 128; nk = 4096; scale = 0.07216878364870323f; }
        else if (br == 1) { Qp = (const bf16_t*)(ws + WS_QG) + (size_t)r * 1024 + h * 128; Kp = (const bf16_t*)(ws + WS_KG) + (size_t)b * SEQ * 256 + (h >> 2) * 128; Vp = (const bf16_t*)(ws + WS_VG) + (size_t)b * SEQ * 256 + (h >> 2) * 128; ldk = 256; ldv = 256; dk = 128; nk = 4096; scale = 0.08838834764831843f; }
        else { Qp = (const bf16_t*)(ws + WS_QM) + (size_t)r * 1024 + h * 256; Kp = (const bf16_t*)(ws + WS_KM) + (size_t)b * 256 * 1024 + h * 256; Vp = (const bf16_t*)(ws + WS_VM) + (size_t)b * 256 * 1024 + h * 256 + 128; ldk = 1024; ldv = 1024; dk = 256; nk = 256; scale = 0.0625f; }
        float p[64]; float m = -1e30f;
#pragma unroll
        for (int j = 0; j < 64; ++j) { const int key = lane + 64 * j; float sdot = -1e30f;
            if (key < nk) { sdot = 0.f; for (int d = 0; d < dk; ++d) sdot += __uint_as_float((unsigned)Qp[d] << 16) * __uint_as_float((unsigned)Kp[(size_t)key * ldk + d] << 16);
                if (Xp) for (int d = 0; d < 64; ++d) sdot += __uint_as_float((unsigned)Qp[128 + d] << 16) * __uint_as_float((unsigned)Xp[(size_t)key * 64 + d] << 16);
                sdot *= scale; }
            p[j] = sdot; m = fmaxf(m, sdot); }
#pragma unroll
        for (int o = 1; o < 64; o <<= 1) m = fmaxf(m, __shfl_xor(m, o));
        float l = 0.f;
#pragma unroll
        for (int j = 0; j < 64; ++j) { p[j] = (lane + 64 * j < nk) ? __expf(p[j] - m) : 0.f; l += p[j]; }
        l = wave_sum(l);
        int bad = 0;
        const int zc = br * 1024 + (br == 2 ? h * 256 + 128 : h * 128);
        for (int d = 0; d < 128; ++d) { float acc = 0.f;
#pragma unroll
            for (int j = 0; j < 64; ++j) { const int key = lane + 64 * j; if (key < nk) acc += p[j] * __uint_as_float((unsigned)Vp[(size_t)key * ldv + d] << 16); }
            acc = wave_sum(acc) / l;
            float zd = 0.f; const bf16_t* wz = (const bf16_t*)(ws + WS_WIN) + (size_t)(3584 + zc + d) * 2048;
            for (int k = lane; k < 2048; k += 64) zd += __uint_as_float((unsigned)H[(size_t)r * 2048 + k] << 16) * __uint_as_float((unsigned)wz[k] << 16);
            zd = wave_sum(zd); const float sz = zd / (1.f + __expf(-zd)); const float szb = __uint_as_float(cvt_pk_bf16(sz, 0.f) << 16);
#ifdef PROBE_NOZ
            const float uref = acc; (void)szb;
#else
            const float uref = acc * szb;
#endif
            const float um = __uint_as_float((unsigned)((const bf16_t*)(ws + WS_Z))[(size_t)r * 3072 + zc + d] << 16);
            if (fabsf(um - uref) > 0.02f * fabsf(uref) + 0.0003f) ++bad; }
        if (lane == 0) { atomicAdd(cnt + 0, 1u); if (bad > 0) atomicAdd(cnt + 1, 1u); }
    }
    if (lo == 21 && bid < 64) {
        unsigned* cnt = (unsigned*)(ws + WS_ZERO + 4096 * 64 * 2 - 32);
        const int w = bid * 8 + wave; const int r = (int)(((long)w * 977 + 13) % T), c = (w * 1543 + 11) % 6144;
        float gd = 0.f; const bf16_t* wg = (const bf16_t*)(ws + WS_WGL) + (size_t)c * 2048;
        for (int k = lane; k < 2048; k += 64) gd += __uint_as_float((unsigned)H[(size_t)r * 2048 + k] << 16) * __uint_as_float((unsigned)wg[k] << 16);
        gd = wave_sum(gd); const float gref = 1.f / (1.f + __expf(-gd)); const float gm = __uint_as_float((unsigned)((const bf16_t*)(ws + WS_GL))[(size_t)r * 6144 + c] << 16);
        if (lane == 0 && fabsf(gm - gref) > 0.005f) atomicAdd(cnt + 4, 1u);
    }
    if (lo == 22 && bid < 64) {
        unsigned* cnt = (unsigned*)(ws + WS_ZERO + 4096 * 64 * 2 - 32);
        const int w = bid * 8 + wave; const int r = (int)(((long)w * 977 + 13) % T), c = (w * 389 + 7) & 2047;
        const bf16_t* GLb = (const bf16_t*)(ws + WS_GL); const bf16_t* Zb = (const bf16_t*)(ws + WS_Z); const bf16_t* WBRb = (const bf16_t*)(ws + WS_WBR); const bf16_t* MG = (const bf16_t*)(ws + WS_MERGED);
        const bf16_t* WO = (const bf16_t*)(ws + WS_WOUT);
        float mref = 0.f;
        for (int i = 0; i < 3; ++i) { float d = 0.f; for (int k = lane; k < 1024; k += 64) d += __uint_as_float((unsigned)Zb[(size_t)r * 3072 + i * 1024 + k] << 16) * __uint_as_float((unsigned)WBRb[((size_t)i * 2048 + c) * 1024 + k] << 16);
            d = wave_sum(d); mref += d * __uint_as_float((unsigned)GLb[(size_t)r * 6144 + i * 2048 + c] << 16); }
        const float mm = __uint_as_float((unsigned)MG[(size_t)r * 2048 + c] << 16);
        float yd = 0.f; for (int k = lane; k < 2048; k += 64) yd += __uint_as_float((unsigned)MG[(size_t)r * 2048 + k] << 16) * __uint_as_float((unsigned)WO[(size_t)c * 2048 + k] << 16);
        yd = wave_sum(yd); const float* xr = r < TP ? xp + (size_t)r * DM : xs + (size_t)(r - TP) * DM; const float yref = xr[c] + yd; const float ym = args.out[(size_t)r * DM + c];
        if (lane == 0) {
            if (fabsf(mm - mref) > 0.015f * fabsf(mref) + 0.0003f) atomicAdd(cnt + 5, 1u);
            if (fabsf(ym - yref) > 0.001f) atomicAdd(cnt + 6, 1u); }
    }
#endif
    if (IN(5)) {
        for (int i = 0; i < 3; ++i) {
            pg8::Gemm g{(const bf16_t*)(ws + WS_H8), (const bf16_t*)(ws + WS_WGL) + (size_t)i * 2048 * 1024, 1024, 1024, T, 2048, 1024}; pg8::StaticOrder S; S.init(T, 2048, G, bid);
            pg8::EpiGL E{(bf16_t*)(ws + WS_GL) + i * 2048, 1.f / (H8_SCALE * W8_SCALE)}; pg8::gemm_phase<pg8::EpiGL, pg8::StaticOrder, true>(lds, g, S, E);
        }
    }
    if constexpr (COOP) { __syncthreads(); }

    if (IN(6)) {
#ifndef PROBE_ZERO
#define PROBE_ZERO -1
#endif
        for (int i = 0; i < 3; ++i) {
            if (i == PROBE_ZERO) continue;
            pg8::Gemm g{(const bf16_t*)(ws + WS_Z) + i * 1024, (const bf16_t*)(ws + WS_WBR) + (size_t)i * 2048 * 1024, 3072, 1024, T, 2048, 1024}; pg8::StaticOrder S; S.init(T, 2048, G, bid);
            pg8::EpiBR E{(const bf16_t*)(ws + WS_GL) + i * 2048, (bf16_t*)(ws + WS_MERGED), i == (PROBE_ZERO == 0 ? 1 : 0)}; pg8::gemm_phase(lds, g, S, E);
        }
    }
    SEAM(6);

    if (IN(7)) {
        pg8::Gemm g{(const bf16_t*)(ws + WS_MERGED), (const bf16_t*)(ws + WS_WOUT), 2048, 2048, T, 2048, 2048}; pg8::StaticOrder S; S.init(T, 2048, G, bid);
        pg8::EpiOut E{xp, xs, args.out, (float*)(ws + WS_SSQ)}; pg8::gemm_phase(lds, g, S, E);
    }
    SEAM(7);


#ifdef PROBE_SCAN
    if (lo == 30) {
        unsigned* cnt = (unsigned*)(ws + WS_ZERO + 4096 * 64 * 2 - 32);
        const size_t gt = (size_t)bid * 512 + tid, gn = (size_t)G * 512;
        unsigned f = 0;
        { const bf16_t* p = (const bf16_t*)(ws + WS_WIN); const size_t n = (WS_TABG - WS_WIN) / 2; for (size_t i = gt; i < n; i += gn) { const float v = __uint_as_float((unsigned)p[i] << 16); if (!(fabsf(v) < 0.5f)) f |= 1u; } }
        { const bf16_t* p = (const bf16_t*)(ws + WS_MERGED); const size_t n = (size_t)T * 2048; for (size_t i = gt; i < n; i += gn) { const float v = __uint_as_float((unsigned)p[i] << 16); if (!(fabsf(v) < 2.0f)) f |= 2u; } }
        { const bf16_t* p = (const bf16_t*)(ws + WS_Z); const size_t n = (size_t)T * 3072; for (size_t i = gt; i < n; i += gn) { const float v = __uint_as_float((unsigned)p[i] << 16); if (!(fabsf(v) < 4.0f)) f |= 4u; } }
        { const bf16_t* p = (const bf16_t*)(ws + WS_GL); const size_t n = (size_t)T * 6144; for (size_t i = gt; i < n; i += gn) { const float v = __uint_as_float((unsigned)p[i] << 16); if (!(v >= 0.f && v <= 1.f)) f |= 8u; } }
        if (f & 1u) atomicAdd(cnt + 1, 1u); if (f & 2u) atomicAdd(cnt + 2, 1u); if (f & 4u) atomicAdd(cnt + 3, 1u); if (f & 8u) atomicAdd(cnt + 4, 1u);
        if (tid == 0) atomicAdd(cnt + 0, 1u);
    }
#endif
#define PH_FINAL 8
    if (IN(PH_FINAL)) {
        const float* gf = args.in[16];
#if defined(PROBE_SCAN)
        const unsigned* cntp = (const unsigned*)(ws + WS_ZERO + 4096 * 64 * 2 - 32);
        unsigned nn[5];
        for (int q = 0; q < 5; ++q) nn[q] = __hip_atomic_load(cntp + q, __ATOMIC_RELAXED, __HIP_MEMORY_SCOPE_AGENT);
        const float pscale = 1.f + (nn[0] == (unsigned)G ? 0.05f : 0.f) + (nn[1] > 0u ? 0.1f : 0.f) + (nn[2] > 0u ? 0.2f : 0.f) + (nn[3] > 0u ? 0.4f : 0.f) + (nn[4] > 0u ? 0.8f : 0.f);
#elif defined(PROBE_CHECK)
        const unsigned* cntp = (const unsigned*)(ws + WS_ZERO + 4096 * 64 * 2 - 32);
        unsigned nn[7];
        for (int q = 0; q < 7; ++q) nn[q] = __hip_atomic_load(cntp + q, __ATOMIC_RELAXED, __HIP_MEMORY_SCOPE_AGENT);
        const float pscale = 1.f + (nn[0] == 2048u ? 0.05f : 0.f) + (float)nn[1] * 0.01f;
#else
        const float pscale = 1.f;
#endif
        for (int r = gw; r < T; r += NGW) {
            f32x4* orow = (f32x4*)(args.out + (size_t)r * DM);
            f32x4 v[8]; float sq = 0.f;
#pragma unroll
            for (int j = 0; j < 8; ++j) { v[j] = orow[lane + 64 * j]; sq += (v[j][0] * v[j][0] + v[j][1] * v[j][1]) + (v[j][2] * v[j][2] + v[j][3] * v[j][3]); }
#ifdef PROBE_NORSTD
            const float rstd = pscale + 0.f * wave_sum(sq);
#else
            const float rstd = pscale / sqrtf(wave_sum(sq) * (1.f / DM) + EPS);
#endif
#pragma unroll
            for (int j = 0; j < 8; ++j) {
#ifdef PROBE_NOGAIN
                const f32x4 gg = (f32x4){1.f, 1.f, 1.f, 1.f};
#else
                const f32x4 gg = ((const f32x4*)gf)[lane + 64 * j];
#endif
                f32x4 w; w[0] = v[j][0] * rstd * gg[0]; w[1] = v[j][1] * rstd * gg[1]; w[2] = v[j][2] * rstd * gg[2]; w[3] = v[j][3] * rstd * gg[3]; orow[lane + 64 * j] = w; }
        }
    }
    __builtin_amdgcn_fence(__ATOMIC_RELEASE, "agent");
#undef IN
#undef SEAM
}

extern "C" void kernel_launch(void* const* d_in, const int* in_sizes, int n_in, void* d_out, int out_size, void* d_ws, size_t ws_size, hipStream_t stream) {
    static int grid = 0;
    if (grid == 0) {
        if (n_in != 17 || out_size != T * DM || ws_size < WS_END) { fprintf(stderr, "kernel_launch: unexpected shapes: n_in %d out %d ws %zu (need %zu)\n", n_in, out_size, ws_size, (size_t)WS_END); grid = -1; return; }
        int dev = 0, cus = 0;
        if (hipGetDevice(&dev) != hipSuccess || hipDeviceGetAttribute(&cus, hipDeviceAttributeMultiprocessorCount, dev) != hipSuccess) { grid = -1; return; }
        if (hipFuncSetAttribute((const void*)mk_fwd<MK_COOP != 0>, hipFuncAttributeMaxDynamicSharedMemorySize, LDS_BYTES) != hipSuccess) { fprintf(stderr, "kernel_launch: hipFuncSetAttribute failed\n"); grid = -1; return; }
        int per_cu = 0;
        if (hipOccupancyMaxActiveBlocksPerMultiprocessor(&per_cu, (const void*)mk_fwd<MK_COOP != 0>, 512, LDS_BYTES) != hipSuccess || per_cu < 1) { fprintf(stderr, "kernel_launch: occupancy query says %d\n", per_cu); per_cu = 1; }
        (void)hipGetLastError();
        grid = cus;
    }
    if (grid < 0) return;
    Args a{};
    for (int i = 0; i < 17; ++i) a.in[i] = (const float*)d_in[i];
    a.out = (float*)d_out; a.ws = (unsigned char*)d_ws;
#if MK_COOP
    (void)hipMemsetAsync((char*)d_ws + WS_BAR, 0, 256, stream);
    a.ph_lo = 0; a.ph_hi = NPHASE;
    void* kargs[] = {&a};
    hipError_t e = hipLaunchCooperativeKernel((const void*)mk_fwd<true>, dim3(grid), dim3(512), kargs, LDS_BYTES, stream);
    if (e != hipSuccess) fprintf(stderr, "kernel_launch: cooperative launch failed: %s (grid %d)\n", hipGetErrorString(e), grid);
#else
#if defined(PROBE_SCAN)
    const int seq_[10] = {0, 1, 2, 3, 4, 5, 6, 7, 30, 8};
    for (int q = 0; q < 10; ++q) { a.ph_lo = seq_[q]; a.ph_hi = seq_[q] + 1; hipLaunchKernelGGL(mk_fwd<false>, dim3(grid), dim3(512), LDS_BYTES, stream, a); }
#elif defined(PROBE_CHECK)
    const int seq_[12] = {0, 1, 2, 3, 4, 20, 5, 21, 6, 7, 22, 8};
    for (int q = 0; q < 12; ++q) { a.ph_lo = seq_[q]; a.ph_hi = seq_[q] + 1; hipLaunchKernelGGL(mk_fwd<false>, dim3(grid), dim3(512), LDS_BYTES, stream, a); }
#else
    for (int p = 0; p < NPHASE; ++p) { a.ph_lo = p; a.ph_hi = p + 1; hipLaunchKernelGGL(mk_fwd<false>, dim3(grid), dim3(512), LDS_BYTES, stream, a); }
#endif
#endif
}
```

```cpp
#include <hip/hip_runtime.h>
#include <hip/hip_cooperative_groups.h>
#include <cstdio>
#include <cstdint>
namespace cg = cooperative_groups;

#define PROBE_BETA 1.0f
#ifndef MK_COOP
#define MK_COOP 1
#endif

#define LAS __attribute__((address_space(3)))
typedef unsigned short bf16_t;
typedef short bf16x8 __attribute__((ext_vector_type(8)));
typedef short s16x4 __attribute__((ext_vector_type(4)));
typedef float f32x2 __attribute__((ext_vector_type(2)));
typedef float f32x4 __attribute__((ext_vector_type(4)));
typedef float f32x16 __attribute__((ext_vector_type(16)));
typedef unsigned u32x2 __attribute__((ext_vector_type(2)));
typedef unsigned u32x4 __attribute__((ext_vector_type(4)));
typedef long l64x2 __attribute__((ext_vector_type(2)));

constexpr int T = 40960, TP = 32768, DM = 2048, SEQ = 4096, NBATCH = 10, MEMROWS = 2560;
constexpr float EPS = 1e-6f;
constexpr int NP1 = 6656;
constexpr size_t WS_WIN = 0;
constexpr size_t WS_WGL = WS_WIN + (size_t)NP1 * 2048 * 2;
constexpr size_t WS_WQB = WS_WGL + (size_t)6144 * 2048 * 2;
constexpr size_t WS_WKVB = WS_WQB + (size_t)1536 * 512 * 2;
constexpr size_t WS_WMKV = WS_WKVB + (size_t)2048 * 256 * 2;
constexpr size_t WS_WBR = WS_WMKV + (size_t)2048 * 2048 * 2;
constexpr size_t WS_WOUT = WS_WBR + (size_t)3 * 2048 * 1024 * 2;
constexpr size_t WS_TABG = WS_WOUT + (size_t)2048 * 2048 * 2;
constexpr size_t WS_TABM = WS_TABG + 64 * 32 * 8;
constexpr size_t WS_GQP = WS_TABM + 64 * 16 * 8;
constexpr size_t WS_GKP = WS_GQP + 512;
constexpr size_t WS_BAR = WS_GKP + 512;
constexpr size_t WS_ZERO = WS_BAR + 256;
constexpr size_t WS_SSQ = WS_ZERO + 4096 * 64 * 2;
constexpr size_t WS_Z = WS_SSQ + (size_t)T * 32 * 4;
constexpr size_t WS_R = WS_Z + (size_t)T * 3072 * 2;
constexpr size_t WS_CQ = WS_R;
constexpr size_t WS_CKV = WS_CQ + (size_t)T * 512 * 2;
constexpr size_t WS_KPE = WS_CKV + (size_t)T * 256 * 2;
constexpr size_t WS_QG = WS_KPE + (size_t)T * 64 * 2;
constexpr size_t WS_KG = WS_QG + (size_t)T * 1024 * 2;
constexpr size_t WS_VG = WS_KG + (size_t)T * 256 * 2;
constexpr size_t WS_QM = WS_VG + (size_t)T * 256 * 2;
constexpr size_t WS_KN = WS_QM + (size_t)T * 1024 * 2;
constexpr size_t WS_VN = WS_KN + (size_t)T * 1024 * 2;
constexpr size_t WS_KM = WS_VN + (size_t)T * 1024 * 2;
constexpr size_t WS_VM = WS_KM + (size_t)MEMROWS * 1024 * 2;
constexpr size_t WS_VMT = WS_VM + (size_t)MEMROWS * 1024 * 2;
constexpr size_t WS_REND = WS_VMT + (size_t)MEMROWS * 1024 * 2;
constexpr size_t WS_GL = WS_R;
constexpr size_t WS_MERGED = WS_GL + (size_t)T * 6144 * 2;
constexpr size_t WS_END = WS_MERGED + (size_t)T * 2048 * 2;
constexpr size_t WS_H8 = WS_MERGED;
constexpr float H8_SCALE = 16.f, W8_SCALE = 64.f;
static_assert(WS_REND <= WS_MERGED, "region R inside GL overlay");
static_assert(WS_END <= (size_t)1 << 30, "d_ws map fits 1 GiB");
constexpr size_t DO_H = 0;
constexpr size_t DO_QMLA = DO_H + (size_t)T * 2048 * 2;
constexpr size_t DO_MN = DO_QMLA + (size_t)T * 1536 * 2;
static_assert(DO_MN + (size_t)MEMROWS * 2048 * 2 <= (size_t)T * 2048 * 4, "d_out scratch");

constexpr int LDS_BYTES = 131072 + 512;

typedef float f32x2_cv __attribute__((ext_vector_type(2)));
typedef __bf16 bf16x2_cv __attribute__((ext_vector_type(2)));
__device__ __forceinline__ unsigned cvt_pk_bf16(float lo, float hi) { unsigned r; asm volatile("v_cvt_pk_bf16_f32 %0, %1, %2" : "=v"(r) : "v"(lo), "v"(hi)); return r; }
__device__ __forceinline__ unsigned cvt_pk_bf16_safe(float lo, float hi) { const f32x2_cv v = {lo, hi}; const bf16x2_cv b = __builtin_convertvector(v, bf16x2_cv); return __builtin_bit_cast(unsigned, b); }
__device__ __forceinline__ u32x4 ld16_coherent(const void* p) { u32x4 v; asm volatile("global_load_dwordx4 %0, %1, off sc1\n\ts_waitcnt vmcnt(0)" : "=v"(v) : "v"(p) : "memory"); return v; }
__device__ __forceinline__ float bf_lo(unsigned w) { return __uint_as_float(w << 16); }
__device__ __forceinline__ float bf_hi(unsigned w) { return __uint_as_float(w & 0xffff0000u); }
__device__ __forceinline__ float wave_sum(float v) {
#pragma unroll
    for (int o = 1; o < 64; o <<= 1) v += __shfl_xor(v, o);
    return v;
}
__device__ __forceinline__ float fast_sigmoid(float v) { return __builtin_amdgcn_rcpf(1.f + __builtin_amdgcn_exp2f(-1.4426950408889634f * v)); }
__device__ __forceinline__ float fast_silu(float v) { return v * fast_sigmoid(v); }

namespace pg8 {
constexpr int BM = 256, BK = 64, HALF = 128, HTB = HALF * BK * 2, STAGE_BYTES = 8 * HTB, NXCD = 8, WGM = 8;
__host__ __device__ __forceinline__ int lds_byte(int r, int c) { const int st = (r >> 4) * 2 + (c >> 5), rr = r & 15, cc = c & 31, ob = rr * 64 + cc * 2; return st * 1024 + (ob ^ (((ob >> 9) & 1) << 5)); }
__host__ __device__ __forceinline__ void stage_rc(int b, int& R, int& C) { const int st = b / 1024, sb = b % 1024, swz = sb ^ (((sb >> 9) & 1) << 5); R = (st >> 1) * 16 + swz / 64; C = (st & 1) * 32 + (swz % 64) / 2; }
__host__ __device__ __forceinline__ int perm32(int rho) { const int n = rho >> 4, i = rho & 15; return 8 * (i >> 2) + 4 * n + (i & 3); }

struct Unit { int pm, pn; };
struct Gemm { const bf16_t* A; const bf16_t* Bt; int lda, ldb, M, N, K; };

struct StaticOrder {
    int nM, nN, nwg, G, c;
    __device__ void init(int M, int N, int G_, int c_) { nM = M / BM; nN = N / BM; nwg = nM * nN; G = G_; c = c_; }
    __device__ bool next(int i, Unit& u) const {
        const long L = (long)i * G + c; if (L >= nwg) return false;
        int wgid = (int)L; { const int q = nwg / NXCD, r = nwg % NXCD, xcd = wgid % NXCD, off = wgid / NXCD; wgid = (xcd < r ? xcd * (q + 1) : r * (q + 1) + (xcd - r) * q) + off; }
        const int nig = WGM * nN, gid = wgid / nig, fm = gid * WGM, gsz = (nM - fm) < WGM ? (nM - fm) : WGM;
        u.pm = fm + ((wgid % nig) % gsz); u.pn = (wgid % nig) / gsz; return true;
    }
};

template <class Epi, class Sched, bool FP8 = false>
__device__ __forceinline__ void gemm_phase(LAS unsigned char* lds, const Gemm g, const Sched& S, const Epi& E) {
    const int tid = threadIdx.x, wid = __builtin_amdgcn_readfirstlane(tid >> 6), lane = tid & 63, wr = wid >> 2, wc = wid & 3, fr = lane & 15, fq = lane >> 4;
    const int K = g.K, nt = K / BK;
    unsigned voffA[2], voffB[2];
#pragma unroll
    for (int i = 0; i < 2; ++i) { int R, C; stage_rc(tid * 16 + i * 8192, R, C); const int Rb = Epi::PERM ? ((R & ~31) + perm32(R & 31)) : R;
        voffA[i] = (unsigned)(R * g.lda + C) * 2u; voffB[i] = (unsigned)(Rb * g.ldb + C) * 2u; }
    const size_t kstep = (size_t)(BK * 2);
    const size_t hstepA = (size_t)HALF * g.lda * 2, hstepB = (size_t)HALF * g.ldb * 2;
    const size_t tstepA = 2 * hstepA, tstepB = 2 * hstepB;
    const unsigned ldsw = (unsigned)wid * 1024u;
    const int aoff = lds_byte(wr * 64 + fr, fq * 8), boff = lds_byte(wc * 32 + fr, fq * 8);
#define PG8_SA(b, h) (((b) * 2 + (h)) * HTB)
#define PG8_SB(b, h) ((4 + (b) * 2 + (h)) * HTB)
#define PG8_STAGE(bufoff, gbase, voff) do { _Pragma("unroll") for (int _i = 0; _i < 2; ++_i) \
        __builtin_amdgcn_global_load_lds((const unsigned*)((const char*)(gbase) + (voff)[_i]), (LAS unsigned*)(lds + (bufoff) + ldsw + _i * 8192), 16, 0, 0); } while (0)
#define PG8_LDA(dst, b, h) do { _Pragma("unroll") for (int m = 0; m < 4; ++m) _Pragma("unroll") for (int k = 0; k < 2; ++k) dst[m][k] = *(const LAS bf16x8*)(lds + PG8_SA(b, h) + aoff + m * 2048 + k * 1024); } while (0)
#define PG8_LDB(dst, b, h) do { _Pragma("unroll") for (int n = 0; n < 2; ++n) _Pragma("unroll") for (int k = 0; k < 2; ++k) dst[n][k] = *(const LAS bf16x8*)(lds + PG8_SB(b, h) + boff + n * 2048 + k * 1024); } while (0)
#define PG8_MMA(ai, bj, At, Bt) do { __builtin_amdgcn_s_setprio(1); _Pragma("unroll") for (int m = 0; m < 4; ++m) _Pragma("unroll") for (int n = 0; n < 2; ++n) _Pragma("unroll") for (int k = 0; k < 2; ++k) { \
        if constexpr (FP8) { const l64x2 b_ = __builtin_bit_cast(l64x2, Bt[n][k]), a_ = __builtin_bit_cast(l64x2, At[m][k]); \
            acc[ai][bj][m][n] = __builtin_amdgcn_mfma_f32_16x16x32_fp8_fp8(b_[0], a_[0], acc[ai][bj][m][n], 0, 0, 0); \
            acc[ai][bj][m][n] = __builtin_amdgcn_mfma_f32_16x16x32_fp8_fp8(b_[1], a_[1], acc[ai][bj][m][n], 0, 0, 0); } \
        else acc[ai][bj][m][n] = __builtin_amdgcn_mfma_f32_16x16x32_bf16(Bt[n][k], At[m][k], acc[ai][bj][m][n], 0, 0, 0); } __builtin_amdgcn_s_setprio(0); } while (0)
#define PG8_WAIT_V(n) asm volatile("s_waitcnt vmcnt(" #n ")" ::: "memory")
#define PG8_WAIT_L(n) asm volatile("s_waitcnt lgkmcnt(" #n ")" ::: "memory")
#define PG8_BAR __builtin_amdgcn_s_barrier()
#define PG8_SCHED __builtin_amdgcn_sched_barrier(0)
    Unit cur, nxt; int ui = 0;
    if (!S.next(0, cur)) return;
    f32x4 acc[2][2][4][2];
#pragma unroll
    for (int a = 0; a < 2; ++a)
#pragma unroll
        for (int b = 0; b < 2; ++b)
#pragma unroll
            for (int m = 0; m < 4; ++m)
#pragma unroll
                for (int n = 0; n < 2; ++n) acc[a][b][m][n] = (f32x4){0.f, 0.f, 0.f, 0.f};
    bf16x8 At[4][2], B0[2][2], B1[2][2];
    const char* cA = (const char*)g.A + (size_t)cur.pm * tstepA; const char* cB = (const char*)g.Bt + (size_t)cur.pn * tstepB;
    PG8_STAGE(PG8_SB(0, 0), cB, voffB); PG8_STAGE(PG8_SB(0, 1), cB + hstepB, voffB); PG8_STAGE(PG8_SA(0, 0), cA, voffA); PG8_STAGE(PG8_SA(0, 1), cA + hstepA, voffA);
    if (wr == 1) PG8_BAR;
    PG8_WAIT_V(2); PG8_BAR;
    PG8_STAGE(PG8_SB(1, 0), cB + kstep, voffB); PG8_STAGE(PG8_SA(1, 0), cA + kstep, voffA); PG8_STAGE(PG8_SB(1, 1), cB + hstepB + kstep, voffB);
    PG8_WAIT_V(6); PG8_BAR;
    for (;;) {
        const bool has_next = S.next(ui + 1, nxt);
        const char* nA = has_next ? (const char*)g.A + (size_t)nxt.pm * tstepA : cA; const char* nB = has_next ? (const char*)g.Bt + (size_t)nxt.pn * tstepB : cB;
        for (int t = 0; t < nt; t += 2) {
            const bool last = (t == nt - 2);
            const char* a1 = cA + (size_t)(t + 1) * kstep;
            const char* a2 = last ? nA : cA + (size_t)(t + 2) * kstep; const char* b2 = last ? nB : cB + (size_t)(t + 2) * kstep;
            const char* a3 = a2 + kstep; const char* b3 = b2 + kstep;
            PG8_LDB(B0, 0, 0); PG8_LDB(B1, 0, 1); PG8_SCHED; PG8_LDA(At, 0, 0); PG8_STAGE(PG8_SA(1, 1), a1 + hstepA, voffA);
            PG8_WAIT_V(8); PG8_WAIT_L(0); PG8_BAR; PG8_MMA(0, 0, At, B0); PG8_MMA(0, 1, At, B1); PG8_BAR; PG8_SCHED;
            PG8_LDA(At, 0, 1); PG8_STAGE(PG8_SB(0, 0), b2, voffB); PG8_STAGE(PG8_SB(0, 1), b2 + hstepB, voffB); PG8_STAGE(PG8_SA(0, 0), a2, voffA);
            PG8_WAIT_V(8); PG8_WAIT_L(0); PG8_BAR; PG8_MMA(1, 0, At, B0); PG8_MMA(1, 1, At, B1); PG8_BAR; PG8_SCHED;
            PG8_LDB(B0, 1, 0); PG8_LDB(B1, 1, 1); PG8_SCHED; PG8_LDA(At, 1, 0); PG8_STAGE(PG8_SA(0, 1), a2 + hstepA, voffA);
            PG8_WAIT_V(8); PG8_WAIT_L(0); PG8_BAR; PG8_MMA(0, 0, At, B0); PG8_MMA(0, 1, At, B1); PG8_BAR; PG8_SCHED;
            PG8_LDA(At, 1, 1); PG8_STAGE(PG8_SB(1, 0), b3, voffB); PG8_STAGE(PG8_SB(1, 1), b3 + hstepB, voffB); PG8_STAGE(PG8_SA(1, 0), a3, voffA);
            PG8_WAIT_V(8); PG8_WAIT_L(0); PG8_BAR; PG8_MMA(1, 0, At, B0); PG8_MMA(1, 1, At, B1); PG8_BAR; PG8_SCHED;
        }
        if (wr == 0) PG8_BAR;
        E(acc, cur, wr, wc, fr, fq);
        if (!has_next) break;
#pragma unroll
        for (int a = 0; a < 2; ++a)
#pragma unroll
            for (int b = 0; b < 2; ++b)
#pragma unroll
                for (int m = 0; m < 4; ++m)
#pragma unroll
                    for (int n = 0; n < 2; ++n) acc[a][b][m][n] = (f32x4){0.f, 0.f, 0.f, 0.f};
        cur = nxt; cA = nA; cB = nB; ++ui;
        if (wr == 1) PG8_BAR;
    }
    PG8_WAIT_V(0);
    PG8_BAR;
#undef PG8_SA
#undef PG8_SB
#undef PG8_STAGE
#undef PG8_LDA
#undef PG8_LDB
#undef PG8_MMA
#undef PG8_WAIT_V
#undef PG8_WAIT_L
#undef PG8_BAR
#undef PG8_SCHED
}

template <class F> __device__ __forceinline__ void epi_loop(const f32x4 (&acc)[2][2][4][2], const Unit& u, int wr, int wc, int fr, int fq, F f) {
#pragma unroll
    for (int ai = 0; ai < 2; ++ai)
#pragma unroll
        for (int m = 0; m < 4; ++m) { const int row = u.pm * BM + ai * HALF + wr * 64 + m * 16 + fr;
#pragma unroll
            for (int bj = 0; bj < 2; ++bj) { const int lc = bj * HALF + wc * 32 + 8 * fq; f(row, lc, acc[ai][bj][m][0], acc[ai][bj][m][1]); } }
}
#define EPI_BEGIN epi_loop(acc, u, wr, wc, fr, fq, [&](int row, int lc, f32x4 v0, f32x4 v1) __attribute__((always_inline)) {
#define EPI_END });

__device__ __forceinline__ u32x4 pack8(f32x4 v0, f32x4 v1) { u32x4 w; w.x = cvt_pk_bf16(v0[0], v0[1]); w.y = cvt_pk_bf16(v0[2], v0[3]); w.z = cvt_pk_bf16(v1[0], v1[1]); w.w = cvt_pk_bf16(v1[2], v1[3]); return w; }

struct EpiP1 {
    static constexpr bool PERM = true;
    unsigned char* ws;
    __device__ __forceinline__ void operator()(const f32x4 (&acc)[2][2][4][2], const Unit& u, int wr, int wc, int fr, int fq) const {
        const int pn = u.pn; bf16_t* dst; int ldc, c0; int mode = 0;
        if (pn < 2) { dst = (bf16_t*)(ws + WS_CQ); ldc = 512; c0 = pn * 256; }
        else if (pn == 2) { dst = (bf16_t*)(ws + WS_CKV); ldc = 256; c0 = 0; }
        else if (pn == 3) { dst = (bf16_t*)(ws + WS_KPE); ldc = 64; c0 = 0; mode = 2; }
        else if (pn < 8) { dst = (bf16_t*)(ws + WS_QG); ldc = 1024; c0 = (pn - 4) * 256; }
        else if (pn == 8) { dst = (bf16_t*)(ws + WS_KG); ldc = 256; c0 = 0; }
        else if (pn == 9) { dst = (bf16_t*)(ws + WS_VG); ldc = 256; c0 = 0; }
        else if (pn < 14) { dst = (bf16_t*)(ws + WS_QM); ldc = 1024; c0 = (pn - 10) * 256; }
        else { dst = (bf16_t*)(ws + WS_Z); ldc = 3072; c0 = (pn - 14) * 256; mode = 1; }
        EPI_BEGIN
            if (mode == 1) {
#pragma unroll
                for (int e = 0; e < 4; ++e) { v0[e] = fast_silu(v0[e]); v1[e] = fast_silu(v1[e]); } }
            if (mode != 2 || lc < 64) *(u32x4*)(dst + (size_t)row * ldc + c0 + lc) = pack8(v0, v1);
        EPI_END
    }
};
struct EpiSplit {
    static constexpr bool PERM = true;
    bf16_t* d0; bf16_t* d1; int ldc;
    __device__ __forceinline__ void operator()(const f32x4 (&acc)[2][2][4][2], const Unit& u, int wr, int wc, int fr, int fq) const {
        bf16_t* dst = u.pn < 4 ? d0 : d1; const int c0 = (u.pn & 3) * 256;
        EPI_BEGIN *(u32x4*)(dst + (size_t)row * ldc + c0 + lc) = pack8(v0, v1); EPI_END
    }
};
struct EpiQ {
    static constexpr bool PERM = true;
    bf16_t* dst; const f32x2* tabm;
    __device__ __forceinline__ void operator()(const f32x4 (&acc)[2][2][4][2], const Unit& u, int wr, int wc, int fr, int fq) const {
        EPI_BEGIN
            const int c = u.pn * 256 + lc; const int d = c % 192;
            if (d >= 128) { const int p0 = d - 128, a = p0 >> 5, i0 = (p0 & 31) >> 1; const int s = row & 4095; const int pos = a ? (s & 63) : (s >> 6);
                const f32x4 cs0 = *(const f32x4*)(tabm + pos * 16 + i0), cs1 = *(const f32x4*)(tabm + pos * 16 + i0 + 2);
                f32x4 r0, r1;
                r0[0] = v0[0] * cs0[0] - v0[1] * cs0[1]; r0[1] = v0[1] * cs0[0] + v0[0] * cs0[1];
                r0[2] = v0[2] * cs0[2] - v0[3] * cs0[3]; r0[3] = v0[3] * cs0[2] + v0[2] * cs0[3];
                r1[0] = v1[0] * cs1[0] - v1[1] * cs1[1]; r1[1] = v1[1] * cs1[0] + v1[0] * cs1[1];
                r1[2] = v1[2] * cs1[2] - v1[3] * cs1[3]; r1[3] = v1[3] * cs1[2] + v1[2] * cs1[3];
                v0 = r0; v1 = r1; }
            *(u32x4*)(dst + (size_t)row * 1536 + c) = pack8(v0, v1);
        EPI_END
    }
};
struct EpiGL {
    static constexpr bool PERM = true;
    bf16_t* dst; float scale;
    __device__ __forceinline__ void operator()(const f32x4 (&acc)[2][2][4][2], const Unit& u, int wr, int wc, int fr, int fq) const {
        EPI_BEGIN
#pragma unroll
            for (int e = 0; e < 4; ++e) { v0[e] = fast_sigmoid(v0[e] * scale); v1[e] = fast_sigmoid(v1[e] * scale); }
            u32x4 w_; w_.x = cvt_pk_bf16_safe(v0[0], v0[1]); w_.y = cvt_pk_bf16_safe(v0[2], v0[3]); w_.z = cvt_pk_bf16_safe(v1[0], v1[1]); w_.w = cvt_pk_bf16_safe(v1[2], v1[3]);
            *(u32x4*)(dst + (size_t)row * 6144 + u.pn * 256 + lc) = w_;
        EPI_END
    }
};
struct EpiBR {
    static constexpr bool PERM = true;
    const bf16_t* gl; bf16_t* merged; int first;
    __device__ __forceinline__ void operator()(const f32x4 (&acc)[2][2][4][2], const Unit& u, int wr, int wc, int fr, int fq) const {
        EPI_BEGIN
            const int c = u.pn * 256 + lc;
            const u32x4 gw = *(const u32x4*)(gl + (size_t)row * 6144 + c);
            bf16_t* mp = merged + (size_t)row * 2048 + c;
            f32x4 p0 = (f32x4){0.f, 0.f, 0.f, 0.f}, p1 = p0;
            if (!first) { const u32x4 pw = *(const u32x4*)mp; p0 = (f32x4){bf_lo(pw.x), bf_hi(pw.x), bf_lo(pw.y), bf_hi(pw.y)}; p1 = (f32x4){bf_lo(pw.z), bf_hi(pw.z), bf_lo(pw.w), bf_hi(pw.w)}; }
            v0[0] = p0[0] + v0[0] * bf_lo(gw.x); v0[1] = p0[1] + v0[1] * bf_hi(gw.x); v0[2] = p0[2] + v0[2] * bf_lo(gw.y); v0[3] = p0[3] + v0[3] * bf_hi(gw.y);
            v1[0] = p1[0] + v1[0] * bf_lo(gw.z); v1[1] = p1[1] + v1[1] * bf_hi(gw.z); v1[2] = p1[2] + v1[2] * bf_lo(gw.w); v1[3] = p1[3] + v1[3] * bf_hi(gw.w);
            *(u32x4*)mp = pack8(v0, v1);
        EPI_END
    }
};
struct EpiOut {
    static constexpr bool PERM = true;
    const float* xp; const float* xs; float* out; float* ssq;
    __device__ __forceinline__ void operator()(const f32x4 (&acc)[2][2][4][2], const Unit& u, int wr, int wc, int fr, int fq) const {
#pragma unroll
        for (int ai = 0; ai < 2; ++ai)
#pragma unroll
            for (int m = 0; m < 4; ++m) { const int row = u.pm * BM + ai * HALF + wr * 64 + m * 16 + fr;
                const float* xr = row < TP ? xp + (size_t)row * DM : xs + (size_t)(row - TP) * DM; float* orow = out + (size_t)row * DM; float sq = 0.f;
#pragma unroll
                for (int bj = 0; bj < 2; ++bj) { const int c = u.pn * 256 + bj * HALF + wc * 32 + 8 * fq;
                    f32x4 v0 = acc[ai][bj][m][0] * PROBE_BETA + *(const f32x4*)(xr + c), v1 = acc[ai][bj][m][1] * PROBE_BETA + *(const f32x4*)(xr + c + 4);
                    sq += (v0[0] * v0[0] + v0[1] * v0[1]) + (v0[2] * v0[2] + v0[3] * v0[3]) + (v1[0] * v1[0] + v1[1] * v1[1]) + (v1[2] * v1[2] + v1[3] * v1[3]);
                    *(f32x4*)(orow + c) = v0; *(f32x4*)(orow + c + 4) = v1; }
                (void)sq; }
    }
};
}

#ifndef ATT_SDX
#define ATT_SDX 1
#endif
#ifndef QKT_SBAR
#define QKT_SBAR SBAR()
#endif
namespace att {
constexpr int QBLK = 32, KVBLK = 64, NW = 8;
constexpr float THR = 8.f;
constexpr int SHM_V = KVBLK * 128 * 2, SHM_K = KVBLK * 128 * 2, SHM_KX = KVBLK * 144;
constexpr int OFF_V = 0, OFF_K = 2 * SHM_V, OFF_KX = OFF_K + 2 * SHM_K, OFF_WS = OFF_KX + 2 * SHM_KX, OFF_QX = OFF_WS + NW * 64 * 4, SHM_ATTN = OFF_QX + NW * 4 * 64 * 16;
static_assert(SHM_ATTN <= 131072, "attention LDS");
#define KSWZ(row, colB) ((row) * 256 + ((colB) ^ (((row) & 7) << 4)))
#define KXSWZ(row, cbi) ((row) * 144 + ((cbi) << 4))
#define SBAR() __builtin_amdgcn_sched_barrier(0)
__device__ __forceinline__ int crow(int r, int hi) { return (r & 3) + 8 * (r >> 2) + 4 * hi; }

template <int SC> __device__ __forceinline__ void partialSM(f32x16& p0, f32x16& p1, float& m_reg, float& mn, float& alpha) {
  constexpr float SCALE = SC == 192 ? 0.07216878364870323f : 0.08838834764831843f;
  constexpr float C = SCALE * 1.4426950408889634f;
  float pmax = p0[0];
#pragma unroll
  for (int r = 1; r < 16; ++r) pmax = fmaxf(pmax, p0[r]);
#pragma unroll
  for (int r = 0; r < 16; ++r) pmax = fmaxf(pmax, p1[r]);
  { auto rr = __builtin_amdgcn_permlane32_swap(__float_as_uint(pmax), __float_as_uint(pmax), false, false);
    pmax = fmaxf(__uint_as_float(rr[0]), __uint_as_float(rr[1])); }
  if (__builtin_expect(__all(pmax - m_reg <= THR / SCALE), 1)) { mn = m_reg; alpha = 1.f; }
  else { mn = fmaxf(m_reg, pmax); alpha = __builtin_amdgcn_exp2f((m_reg - mn) * C); m_reg = mn; }
  float mnC = -mn * C;
#pragma unroll
  for (int r = 0; r < 16; ++r) p0[r] = fmaf(p0[r], C, mnC);
#pragma unroll
  for (int r = 0; r < 16; ++r) p1[r] = fmaf(p1[r], C, mnC);
#pragma unroll
  for (int r = 0; r < 16; ++r) p0[r] = __builtin_amdgcn_exp2f(p0[r]);
}
__device__ __forceinline__ void finishSM(f32x16& p0, f32x16& p1, float alpha, float& l_reg, bf16x8& pa0, bf16x8& pa1, bf16x8& pa2, bf16x8& pa3) {
#pragma unroll
  for (int r = 0; r < 16; ++r) p1[r] = __builtin_amdgcn_exp2f(p1[r]);
  float ps = 0;
#pragma unroll
  for (int r = 0; r < 16; ++r) ps += p0[r];
#pragma unroll
  for (int r = 0; r < 16; ++r) ps += p1[r];
  { auto rr = __builtin_amdgcn_permlane32_swap(__float_as_uint(ps), __float_as_uint(ps), false, false);
    ps = __uint_as_float(rr[0]) + __uint_as_float(rr[1]); }
  l_reg = l_reg * alpha + ps;
  SBAR();
#define PK4(P, BASE, OUT) do { unsigned a0 = cvt_pk_bf16(P[BASE + 0], P[BASE + 1]), a1 = cvt_pk_bf16(P[BASE + 2], P[BASE + 3]);   \
    unsigned b0 = cvt_pk_bf16(P[BASE + 4], P[BASE + 5]), b1 = cvt_pk_bf16(P[BASE + 6], P[BASE + 7]);                              \
    auto r0 = __builtin_amdgcn_permlane32_swap(a0, b0, false, false); auto r1 = __builtin_amdgcn_permlane32_swap(a1, b1, false, false); \
    u32x4 w = {r0[0], r1[0], r0[1], r1[1]}; OUT = *reinterpret_cast<bf16x8*>(&w); } while (0)
  PK4(p0, 0, pa0); PK4(p0, 8, pa1); PK4(p1, 0, pa2); PK4(p1, 8, pa3);
#undef PK4
}
template <int DKX> __device__ __forceinline__ void qkt(f32x16& p0, f32x16& p1, const LAS char* Ks, const LAS char* Kxs, const bf16x8* qr, const LAS char* qx, int r32, int hi) {
  p0 = f32x16{}; p1 = f32x16{};
#pragma unroll
  for (int d0 = 0; d0 < 8; ++d0) { int cb = (d0 * 16 + hi * 8) * 2;
    bf16x8 b0 = *(const LAS bf16x8*)(Ks + KSWZ(r32, cb));
    bf16x8 b1 = *(const LAS bf16x8*)(Ks + KSWZ(32 + r32, cb));
    p0 = __builtin_amdgcn_mfma_f32_32x32x16_bf16(b0, qr[d0], p0, 0, 0, 0);
    p1 = __builtin_amdgcn_mfma_f32_32x32x16_bf16(b1, qr[d0], p1, 0, 0, 0); }
  if constexpr (DKX > 0) {
    int zz = 0; asm volatile("" : "+v"(zz)); qx += zz;
    const LAS char* kxp = Kxs + KXSWZ(r32, hi);
#pragma unroll
    for (int dx = 0; dx < DKX / 16; ++dx) {
      bf16x8 b0 = *(const LAS bf16x8*)(kxp + dx * 32);
      bf16x8 b1 = *(const LAS bf16x8*)(kxp + dx * 32 + 32 * 144);
      const bf16x8 qf = *(const LAS bf16x8*)(qx + dx * 1024);
      p0 = __builtin_amdgcn_mfma_f32_32x32x16_bf16(b0, qf, p0, 0, 0, 0);
      p1 = __builtin_amdgcn_mfma_f32_32x32x16_bf16(b1, qf, p1, 0, 0, 0); }
  }
}
__device__ __forceinline__ int v_st(int k, int c) { const int kk = (k & ~0xC) | ((k & 4) << 1) | ((k & 8) >> 1); return ((kk >> 3) * 4 + (c >> 5)) * 512 + ((kk & 7) * 32 + (c & 31)) * 2; }
__device__ __forceinline__ int v_rd_base(int lane) { return ((lane & 3) << 3) | (((lane >> 2) & 3) << 6) | (((lane >> 4) & 1) << 5) | (((lane >> 5) & 1) << 8); }
constexpr int v_rd_off(int d0, int ks, int half) { return d0 * 512 + ks * 4096 + half * 2048; }
template <int OFF> __device__ __forceinline__ s16x4 tr_read(int vb) {
  s16x4 r; asm volatile("ds_read_b64_tr_b16 %0, %1 offset:%2" : "=&v"(r) : "v"(vb), "i"(OFF) : "memory"); return r;
}
template <int D0> __device__ __forceinline__ void pv_one(f32x16& od, int vb, bf16x8 pa0, bf16x8 pa1, bf16x8 pa2, bf16x8 pa3) {
  const s16x4 l0 = tr_read<v_rd_off(D0, 0, 0)>(vb), h0 = tr_read<v_rd_off(D0, 0, 1)>(vb), l1 = tr_read<v_rd_off(D0, 1, 0)>(vb), h1 = tr_read<v_rd_off(D0, 1, 1)>(vb);
  const s16x4 l2 = tr_read<v_rd_off(D0, 2, 0)>(vb), h2 = tr_read<v_rd_off(D0, 2, 1)>(vb), l3 = tr_read<v_rd_off(D0, 3, 0)>(vb), h3 = tr_read<v_rd_off(D0, 3, 1)>(vb);
  asm volatile("s_waitcnt lgkmcnt(0)" ::: "memory"); SBAR();
#define PK(L, H) (bf16x8){L[0], L[1], L[2], L[3], H[0], H[1], H[2], H[3]}
  od = __builtin_amdgcn_mfma_f32_32x32x16_bf16(pa0, PK(l0, h0), od, 0, 0, 0);
  od = __builtin_amdgcn_mfma_f32_32x32x16_bf16(pa1, PK(l1, h1), od, 0, 0, 0);
  od = __builtin_amdgcn_mfma_f32_32x32x16_bf16(pa2, PK(l2, h2), od, 0, 0, 0);
  od = __builtin_amdgcn_mfma_f32_32x32x16_bf16(pa3, PK(l3, h3), od, 0, 0, 0);
#undef PK
}
__device__ __forceinline__ void pv_d0(f32x16* o, int vb, bf16x8 pa0, bf16x8 pa1, bf16x8 pa2, bf16x8 pa3) {
  pv_one<0>(o[0], vb, pa0, pa1, pa2, pa3); pv_one<1>(o[1], vb, pa0, pa1, pa2, pa3); pv_one<2>(o[2], vb, pa0, pa1, pa2, pa3); pv_one<3>(o[3], vb, pa0, pa1, pa2, pa3);
}

template <int DKX, int LDQ, int LDK, int LDV, int SC>
__device__ __forceinline__ void attn_unit(const bf16_t* __restrict__ Qb, const bf16_t* __restrict__ Kh, const bf16_t* __restrict__ Kx, const bf16_t* __restrict__ Vh,
                                          bf16_t* Zb, int seq, LAS char* lds) {
  constexpr int SDEPTH = (DKX > 0) ? ATT_SDX : 2; constexpr int NQ = 8; constexpr int LDO = 3072;
  int tid = threadIdx.x; asm volatile("" : "+v"(tid));
  const int wid = tid >> 6, lane = tid & 63, r32 = lane & 31, hi = lane >> 5;
  LAS char* V_lds = lds + OFF_V; LAS char* K_lds = lds + OFF_K; LAS char* KX_lds = lds + OFF_KX;
  LAS float* ws = (LAS float*)(lds + OFF_WS) + wid * 64; LAS float* li_l = ws; LAS float* al_l = ws + 32;
  float m_reg = -1e30f, l_reg = 0; f32x16 o[4] = {}; bf16x8 qr[NQ];
  const bf16_t* Qw = Qb + (long)(wid * QBLK + r32) * LDQ + hi * 8;
#pragma unroll
  for (int d0 = 0; d0 < NQ; ++d0) qr[d0] = *reinterpret_cast<const bf16x8*>(Qw + d0 * 16);
  LAS char* qx = lds + OFF_QX + (wid * 256 + lane) * 16;
  if constexpr (DKX > 0) {
#pragma unroll
    for (int dx = 0; dx < DKX / 16; ++dx) *(LAS bf16x8*)(qx + dx * 1024) = *reinterpret_cast<const bf16x8*>(Qw + 128 + dx * 16);
  }
  const int sr = tid >> 4, sc = (tid & 15) * 8, vst0 = v_st(sr, sc), vst1 = v_st(32 + sr, sc);
  const int xr = tid >> 3, xc = tid & 7, kxst = KXSWZ(xr, xc);
  const int vb0 = (int)(unsigned)(uintptr_t)V_lds + v_rd_base(lane);
  const unsigned vof0 = (unsigned)(sr * LDV + sc), vof1 = vof0 + 32u * LDV, kof0 = (unsigned)(sr * LDK + sc), kof1 = kof0 + 32u * LDK, xof = (unsigned)(xr * 64 + xc * 8);
  struct { bf16x8 vs0, vs1, ks0, ks1, kx; } sr_[SDEPTH];
#define SLOAD(i, k0) do { const bf16_t* Vt_ = Vh + (size_t)(k0) * LDV; const bf16_t* Kt_ = Kh + (size_t)(k0) * LDK; \
    sr_[i].vs0 = *reinterpret_cast<const bf16x8*>(Vt_ + vof0); sr_[i].vs1 = *reinterpret_cast<const bf16x8*>(Vt_ + vof1); \
    sr_[i].ks0 = *reinterpret_cast<const bf16x8*>(Kt_ + kof0); sr_[i].ks1 = *reinterpret_cast<const bf16x8*>(Kt_ + kof1); \
    if constexpr (DKX > 0) { const bf16_t* Xt_ = Kx + (size_t)(k0) * 64; sr_[i].kx = *reinterpret_cast<const bf16x8*>(Xt_ + xof); } } while (0)
#define SWRITE(b, i) do { *(LAS bf16x8*)(V_lds + (b) * SHM_V + vst0) = sr_[i].vs0;          \
    *(LAS bf16x8*)(V_lds + (b) * SHM_V + vst1) = sr_[i].vs1; int kc = sc * 2;               \
    *(LAS bf16x8*)(K_lds + (b) * SHM_K + KSWZ(sr, kc)) = sr_[i].ks0;                       \
    *(LAS bf16x8*)(K_lds + (b) * SHM_K + KSWZ(32 + sr, kc)) = sr_[i].ks1;                   \
    if constexpr (DKX > 0) *(LAS bf16x8*)(KX_lds + (b) * SHM_KX + kxst) = sr_[i].kx; } while (0)
#define SWAIT() do { if constexpr (SDEPTH == 1) asm volatile("s_waitcnt vmcnt(0)" ::: "memory"); else if constexpr (DKX > 0) asm volatile("s_waitcnt vmcnt(5)" ::: "memory"); else asm volatile("s_waitcnt vmcnt(4)" ::: "memory"); } while (0)
#define RESC(a) do { if (__any((a) < 1.f)) { if (hi == 0) al_l[r32] = (a); asm volatile("s_waitcnt lgkmcnt(0)" ::: "memory"); \
    _Pragma("unroll") for (int d = 0; d < 4; ++d) _Pragma("unroll") for (int r = 0; r < 16; ++r) o[d][r] *= al_l[crow(r, hi)]; } } while (0)
  f32x16 pA0, pA1, pB0, pB1; float mnA, mnB, alA, alB; bf16x8 pa0, pa1, pa2, pa3; const int NT = seq / KVBLK;
  constexpr int SE = 0, SO = SDEPTH - 1;
  SLOAD(SE, 0); asm volatile("s_waitcnt vmcnt(0)" ::: "memory"); SWRITE(0, SE); __syncthreads();
  qkt<DKX>(pA0, pA1, K_lds, KX_lds, qr, qx, r32, hi); partialSM<SC>(pA0, pA1, m_reg, mnA, alA);
  SLOAD(SO, KVBLK); if constexpr (SDEPTH == 2) { if (2 < NT) SLOAD(SE, 2 * KVBLK); }
  SWAIT(); SWRITE(1, SO); __syncthreads();
  for (int j = 1; j + 1 < NT; j += 2) {
    SBAR(); qkt<DKX>(pB0, pB1, K_lds + SHM_K, KX_lds + SHM_KX, qr, qx, r32, hi);
    finishSM(pA0, pA1, alA, l_reg, pa0, pa1, pa2, pa3); SBAR();
    SLOAD(SO, (j + SDEPTH) * KVBLK); SBAR();
    pv_d0(o, vb0, pa0, pa1, pa2, pa3); partialSM<SC>(pB0, pB1, m_reg, mnB, alB);
    __syncthreads(); SWAIT(); SWRITE(0, SE);
    RESC(alB); __syncthreads();
    SBAR(); qkt<DKX>(pA0, pA1, K_lds, KX_lds, qr, qx, r32, hi);
    finishSM(pB0, pB1, alB, l_reg, pa0, pa1, pa2, pa3); SBAR();
    if (SDEPTH == 1 || j + 3 < NT) SLOAD(SE, (j + 1 + SDEPTH) * KVBLK); SBAR();
    pv_d0(o, vb0 + (int)SHM_V, pa0, pa1, pa2, pa3); partialSM<SC>(pA0, pA1, m_reg, mnA, alA);
    __syncthreads(); SWAIT(); SWRITE(1, SO);
    RESC(alA); __syncthreads();
  }
  SBAR(); qkt<DKX>(pB0, pB1, K_lds + SHM_K, KX_lds + SHM_KX, qr, qx, r32, hi);
  finishSM(pA0, pA1, alA, l_reg, pa0, pa1, pa2, pa3); SBAR();
  pv_d0(o, vb0, pa0, pa1, pa2, pa3); partialSM<SC>(pB0, pB1, m_reg, mnB, alB);
  __syncthreads(); RESC(alB);
  finishSM(pB0, pB1, alB, l_reg, pa0, pa1, pa2, pa3); SBAR();
  pv_d0(o, vb0 + (int)SHM_V, pa0, pa1, pa2, pa3);
  if (hi == 0) li_l[r32] = l_reg; asm volatile("s_waitcnt lgkmcnt(0)" ::: "memory");
#pragma unroll
  for (int r = 0; r < 16; ++r) { const float rl_ = __builtin_amdgcn_rcpf(li_l[crow(r, hi)]);
#pragma unroll
    for (int d0 = 0; d0 < 4; ++d0) o[d0][r] *= rl_; }
  __syncthreads();
  LAS char* ew = lds + OFF_V + wid * 8192;
#pragma unroll
  for (int d0 = 0; d0 < 4; ++d0)
#pragma unroll
    for (int r = 0; r < 16; ++r) *(LAS bf16_t*)(ew + crow(r, hi) * 256 + (d0 * 32 + r32) * 2) = (bf16_t)(cvt_pk_bf16(o[d0][r], 0.f) & 0xffffu);
  bf16_t* Zw = Zb + (long)(wid * QBLK) * LDO;
  u32x4 zq[8];
#pragma unroll
  for (int j = 0; j < 8; ++j) { const int c = lane + 64 * j; zq[j] = *(const u32x4*)(Zw + (long)(c >> 4) * LDO + (c & 15) * 8); }
#pragma unroll
  for (int j = 0; j < 8; ++j) { const int c = lane + 64 * j; const u32x4 ov = *(const LAS u32x4*)(ew + (c >> 4) * 256 + (c & 15) * 16); u32x4 w;
    w.x = cvt_pk_bf16(bf_lo(ov.x) * bf_lo(zq[j].x), bf_hi(ov.x) * bf_hi(zq[j].x)); w.y = cvt_pk_bf16(bf_lo(ov.y) * bf_lo(zq[j].y), bf_hi(ov.y) * bf_hi(zq[j].y));
    w.z = cvt_pk_bf16(bf_lo(ov.z) * bf_lo(zq[j].z), bf_hi(ov.z) * bf_hi(zq[j].z)); w.w = cvt_pk_bf16(bf_lo(ov.w) * bf_lo(zq[j].w), bf_hi(ov.w) * bf_hi(zq[j].w));
    *(u32x4*)(Zw + (long)(c >> 4) * LDO + (c & 15) * 8) = w; }
  __syncthreads();
#undef SLOAD
#undef SWRITE
#undef SWAIT
#undef RESC
}
}

__device__ __forceinline__ void mem_attn_wave(const bf16_t* __restrict__ QM, const bf16_t* __restrict__ KM, const bf16_t* __restrict__ VMT, bf16_t* Z, int b, int h, int rg, int lane) {
    const int jr = lane & 15, q = lane >> 4;
    const size_t row = (size_t)b * SEQ + rg * 16 + jr;
    bf16x8 qf[8];
#pragma unroll
    for (int c = 0; c < 8; ++c) qf[c] = *(const bf16x8*)(QM + row * 1024 + h * 256 + 32 * c + 8 * q);
    f32x4 S[16];
    const bf16_t* kb = KM + ((size_t)b * 256 + jr) * 1024 + h * 256 + 8 * q;
#pragma unroll
    for (int n = 0; n < 16; ++n) { f32x4 acc = (f32x4){0.f, 0.f, 0.f, 0.f};
#pragma unroll
        for (int c = 0; c < 8; ++c) { const bf16x8 kf = *(const bf16x8*)(kb + (size_t)n * 16 * 1024 + 32 * c); acc = __builtin_amdgcn_mfma_f32_16x16x32_bf16(kf, qf[c], acc, 0, 0, 0); }
        S[n] = acc; }
    float m = -1e30f;
#pragma unroll
    for (int n = 0; n < 16; ++n) m = fmaxf(fmaxf(fmaxf(S[n][0], S[n][1]), fmaxf(S[n][2], S[n][3])), m);
    m = fmaxf(m, __shfl_xor(m, 16)); m = fmaxf(m, __shfl_xor(m, 32));
    constexpr float C = 0.0625f * 1.4426950408889634f; const float mC = -m * C; float l = 0.f;
#pragma unroll
    for (int n = 0; n < 16; ++n)
#pragma unroll
        for (int e = 0; e < 4; ++e) { const float p = __builtin_amdgcn_exp2f(fmaf(S[n][e], C, mC)); S[n][e] = p; l += p; }
    l += __shfl_xor(l, 16); l += __shfl_xor(l, 32);
    const float rl = __builtin_amdgcn_rcpf(l);
    __builtin_amdgcn_sched_barrier(0);
    bf16x8 pf[8];
#pragma unroll
    for (int c = 0; c < 8; ++c) { u32x4 w; w.x = cvt_pk_bf16(S[2 * c][0], S[2 * c][1]); w.y = cvt_pk_bf16(S[2 * c][2], S[2 * c][3]); w.z = cvt_pk_bf16(S[2 * c + 1][0], S[2 * c + 1][1]); w.w = cvt_pk_bf16(S[2 * c + 1][2], S[2 * c + 1][3]);
        pf[c] = *reinterpret_cast<bf16x8*>(&w); }
    const bf16_t* vb = VMT + ((size_t)h * 256 + jr) * MEMROWS + b * 256 + 8 * q;
    bf16_t* zrow = Z + row * 3072 + 2048 + h * 256 + 4 * q;
    u32x2 zz[16];
#pragma unroll
    for (int n = 0; n < 16; ++n) zz[n] = *(const u32x2*)(zrow + 16 * n);
#pragma unroll
    for (int n = 0; n < 16; ++n) { f32x4 acc = (f32x4){0.f, 0.f, 0.f, 0.f};
#pragma unroll
        for (int c = 0; c < 8; ++c) { const bf16x8 vf = *(const bf16x8*)(vb + (size_t)n * 16 * MEMROWS + 32 * c); acc = __builtin_amdgcn_mfma_f32_16x16x32_bf16(vf, pf[c], acc, 0, 0, 0); }
        u32x2 w; w.x = cvt_pk_bf16(acc[0] * rl * bf_lo(zz[n].x), acc[1] * rl * bf_hi(zz[n].x)); w.y = cvt_pk_bf16(acc[2] * rl * bf_lo(zz[n].y), acc[3] * rl * bf_hi(zz[n].y));
        *(u32x2*)(zrow + 16 * n) = w; }
}


__device__ __forceinline__ void mem_attn_block(const bf16_t* __restrict__ QM, const bf16_t* __restrict__ KM, const bf16_t* __restrict__ VMT, bf16_t* Z, int b, int h, int rb, LAS unsigned char* lds, int tid_in) {
    int tid = tid_in; asm volatile("" : "+v"(tid));
    const int wave = tid >> 6, lane = tid & 63, jr = lane & 15, q = lane >> 4;
    const size_t row = (size_t)b * SEQ + rb * 128 + wave * 16 + jr;
    {
        u32x4 st[16];
#pragma unroll
        for (int i = 0; i < 16; ++i) { const int g = tid + 512 * i, r_ = g >> 5, ch = g & 31; st[i] = *(const u32x4*)(KM + ((size_t)b * 256 + r_) * 1024 + h * 256 + ch * 8); }
#pragma unroll
        for (int i = 0; i < 16; ++i) { const int g = tid + 512 * i, r_ = g >> 5, ch = g & 31; *(LAS u32x4*)(lds + r_ * 512 + ((ch ^ (r_ & 15)) << 4)) = st[i]; }
    }
    bf16x8 qf[8];
#pragma unroll
    for (int c = 0; c < 8; ++c) qf[c] = *(const bf16x8*)(QM + row * 1024 + h * 256 + 32 * c + 8 * q);
    __syncthreads();
    f32x4 S[16];
#pragma unroll
    for (int n = 0; n < 16; ++n) { f32x4 acc = (f32x4){0.f, 0.f, 0.f, 0.f};
#pragma unroll
        for (int c = 0; c < 8; ++c) { const bf16x8 kf = *(const LAS bf16x8*)(lds + (16 * n + jr) * 512 + (((4 * c + q) ^ jr) << 4)); acc = __builtin_amdgcn_mfma_f32_16x16x32_bf16(kf, qf[c], acc, 0, 0, 0); }
        S[n] = acc; __builtin_amdgcn_sched_barrier(0); }
    float m = -1e30f;
#pragma unroll
    for (int n = 0; n < 16; ++n) m = fmaxf(fmaxf(fmaxf(S[n][0], S[n][1]), fmaxf(S[n][2], S[n][3])), m);
    m = fmaxf(m, __shfl_xor(m, 16)); m = fmaxf(m, __shfl_xor(m, 32));
    constexpr float C = 0.0625f * 1.4426950408889634f; const float mC = -m * C; float l = 0.f;
#pragma unroll
    for (int n = 0; n < 16; ++n)
#pragma unroll
        for (int e = 0; e < 4; ++e) { const float p = __builtin_amdgcn_exp2f(fmaf(S[n][e], C, mC)); S[n][e] = p; l += p; }
    l += __shfl_xor(l, 16); l += __shfl_xor(l, 32);
    const float rl = __builtin_amdgcn_rcpf(l);
    __builtin_amdgcn_sched_barrier(0);
    bf16x8 pf[8];
#pragma unroll
    for (int c = 0; c < 8; ++c) { u32x4 w; w.x = cvt_pk_bf16(S[2 * c][0], S[2 * c][1]); w.y = cvt_pk_bf16(S[2 * c][2], S[2 * c][3]); w.z = cvt_pk_bf16(S[2 * c + 1][0], S[2 * c + 1][1]); w.w = cvt_pk_bf16(S[2 * c + 1][2], S[2 * c + 1][3]);
        pf[c] = *reinterpret_cast<bf16x8*>(&w); }
    bf16_t* zrow = Z + row * 3072 + 2048 + h * 256 + 4 * q;
    u32x2 zz[16];
#pragma unroll
    for (int n = 0; n < 16; ++n) zz[n] = *(const u32x2*)(zrow + 16 * n);
    __syncthreads();
    {
        u32x4 st[16];
#pragma unroll
        for (int i = 0; i < 16; ++i) { const int g = tid + 512 * i, r_ = g >> 5, ch = g & 31; st[i] = *(const u32x4*)(VMT + ((size_t)h * 256 + r_) * MEMROWS + b * 256 + ch * 8); }
#pragma unroll
        for (int i = 0; i < 16; ++i) { const int g = tid + 512 * i, r_ = g >> 5, ch = g & 31; *(LAS u32x4*)(lds + r_ * 512 + ((ch ^ (r_ & 15)) << 4)) = st[i]; }
    }
    __syncthreads();
#pragma unroll
    for (int n = 0; n < 16; ++n) { f32x4 acc = (f32x4){0.f, 0.f, 0.f, 0.f};
#pragma unroll
        for (int c = 0; c < 8; ++c) { const bf16x8 vf = *(const LAS bf16x8*)(lds + (16 * n + jr) * 512 + (((4 * c + q) ^ jr) << 4)); acc = __builtin_amdgcn_mfma_f32_16x16x32_bf16(vf, pf[c], acc, 0, 0, 0); }
        u32x2 w; w.x = cvt_pk_bf16(acc[0] * rl * bf_lo(zz[n].x), acc[1] * rl * bf_hi(zz[n].x)); w.y = cvt_pk_bf16(acc[2] * rl * bf_lo(zz[n].y), acc[3] * rl * bf_hi(zz[n].y));
        *(u32x2*)(zrow + 16 * n) = w; __builtin_amdgcn_sched_barrier(0); }
    __syncthreads();
}

__device__ __forceinline__ int gperm_inv128(int p) { const int a = p >> 6, t = p & 63; return 64 * a + 32 * (t & 1) + (t >> 1); }
__device__ __forceinline__ int gperm_inv64(int p) { const int a = p >> 5, t = p & 31; return 32 * a + 16 * (t & 1) + (t >> 1); }
__device__ __forceinline__ int colmap(int kind, int n) {
    if (kind == 0) {
        if (n < 768) return n;
        if (n < 1024) { const int j = n - 768; return j < 64 ? 768 + gperm_inv64(j) : -1; }
        if (n < 2048) { const int j = n - 1024; return 832 + (j & ~127) + gperm_inv128(j & 127); }
        if (n < 2304) { const int j = n - 2048; return 1856 + (j & ~127) + gperm_inv128(j & 127); }
        return n - 2304 + 2112;
    }
    if (kind == 1) return 6464 + n;
    if (kind == 2) { const int h = n / 192, d = n % 192; return h * 192 + (d < 128 ? d : 128 + gperm_inv64(d - 128)); }
    if (kind == 3) { if (n < 1024) return (n >> 7) * 256 + (n & 127); const int m = n - 1024; return (m >> 7) * 256 + 128 + (m & 127); }
    return n;
}
__device__ __forceinline__ void transpose_item(const float* __restrict__ W, int ldw, int K, bf16_t* WT, int kind, int item, LAS unsigned char* scr, int tid) {
    const int nkb = K >> 6; const int nb = item / nkb, kb = item - nb * nkb; const int n0 = nb * 64, k0 = kb * 64;
    const int nl = tid & 63, kg = tid >> 6;
    const int col = colmap(kind, n0 + nl);
    float v[8];
#pragma unroll
    for (int j = 0; j < 8; ++j) v[j] = col >= 0 ? W[(size_t)(k0 + 8 * kg + j) * ldw + col] : 0.f;
    u32x4 o; o.x = cvt_pk_bf16(v[0], v[1]); o.y = cvt_pk_bf16(v[2], v[3]); o.z = cvt_pk_bf16(v[4], v[5]); o.w = cvt_pk_bf16(v[6], v[7]);
    *(LAS u32x4*)(scr + nl * 144 + kg * 16) = o;
    __syncthreads();
    const int row = tid >> 3, ch = tid & 7;
    const u32x4 w = *(const LAS u32x4*)(scr + row * 144 + ch * 16);
    *(u32x4*)(WT + (size_t)(n0 + row) * K + k0 + 8 * ch) = w;
    __syncthreads();
}

__device__ __forceinline__ unsigned pk4_fp8(float a, float b, float c, float d) { int w = __builtin_amdgcn_cvt_pk_fp8_f32(a, b, 0, false); w = __builtin_amdgcn_cvt_pk_fp8_f32(c, d, w, true); return (unsigned)w; }
__device__ __forceinline__ void transpose_item_fp8(const float* __restrict__ W, int ldw, int K, unsigned char* WT, int col0, int item, LAS unsigned char* scr, int tid) {
    const int nkb = K >> 6; const int nb = item / nkb, kb = item - nb * nkb; const int n0 = nb * 64, k0 = kb * 64;
    const int nl = tid & 63, kg = tid >> 6;
    float v[8];
#pragma unroll
    for (int j = 0; j < 8; ++j) v[j] = W8_SCALE * W[(size_t)(k0 + 8 * kg + j) * ldw + col0 + n0 + nl];
    u32x2 o; o.x = pk4_fp8(v[0], v[1], v[2], v[3]); o.y = pk4_fp8(v[4], v[5], v[6], v[7]);
    *(LAS u32x2*)(scr + nl * 72 + kg * 8) = o;
    __syncthreads();
    const int row = tid >> 3, ch = tid & 7;
    const u32x2 w = *(const LAS u32x2*)(scr + row * 72 + ch * 8);
    *(u32x2*)(WT + (size_t)(n0 + row) * K + k0 + 8 * ch) = w;
    __syncthreads();
}
__device__ __forceinline__ void rms_row_to_bf16(const float* __restrict__ xrow, const float* __restrict__ g, bf16_t* orow, unsigned char* o8row, int lane) {
    f32x4 v[8]; float s = 0.f;
#pragma unroll
    for (int j = 0; j < 8; ++j) { v[j] = ((const f32x4*)xrow)[lane + 64 * j]; s += (v[j][0] * v[j][0] + v[j][1] * v[j][1]) + (v[j][2] * v[j][2] + v[j][3] * v[j][3]); }
    const float rstd = 1.0f / sqrtf(wave_sum(s) * (1.f / DM) + EPS);
#pragma unroll
    for (int j = 0; j < 8; ++j) { const f32x4 gg = ((const f32x4*)g)[lane + 64 * j]; u32x2 w; w.x = cvt_pk_bf16(v[j][0] * rstd * gg[0], v[j][1] * rstd * gg[1]); w.y = cvt_pk_bf16(v[j][2] * rstd * gg[2], v[j][3] * rstd * gg[3]);
        ((u32x2*)orow)[lane + 64 * j] = w;
        if (o8row) ((unsigned*)o8row)[lane + 64 * j] = pk4_fp8(H8_SCALE * v[j][0] * rstd * gg[0], H8_SCALE * v[j][1] * rstd * gg[1], H8_SCALE * v[j][2] * rstd * gg[2], H8_SCALE * v[j][3] * rstd * gg[3]); }
}
__device__ __forceinline__ void sincos_d(float angf, float& c, float& s) {
    const double a = (double)angf; const double kq = rint(a * 0.63661977236758134308); const double r = a - kq * 1.57079632679489661923; const int qd = ((int)kq) & 3;
    const double r2 = r * r;
    const double sp = r * (1.0 + r2 * (-1.0 / 6 + r2 * (1.0 / 120 + r2 * (-1.0 / 5040 + r2 * (1.0 / 362880 + r2 * (-1.0 / 39916800 + r2 * (1.0 / 6227020800.0)))))));
    const double cp = 1.0 + r2 * (-0.5 + r2 * (1.0 / 24 + r2 * (-1.0 / 720 + r2 * (1.0 / 40320 + r2 * (-1.0 / 3628800 + r2 * (1.0 / 479001600 + r2 * (-1.0 / 87178291200.0)))))));
    double sv, cv;
    if (qd == 0) { sv = sp; cv = cp; } else if (qd == 1) { sv = cp; cv = -sp; } else if (qd == 2) { sv = -sp; cv = -cp; } else { sv = -cp; cv = sp; }
    c = (float)cv; s = (float)sv;
}

__device__ __forceinline__ void grid_barrier(unsigned* ctr, unsigned target) {
    __syncthreads();
    if (threadIdx.x == 0) {
        __builtin_amdgcn_fence(__ATOMIC_RELEASE, "agent");
        __hip_atomic_fetch_add(ctr, 1u, __ATOMIC_RELAXED, __HIP_MEMORY_SCOPE_AGENT);
        while (__hip_atomic_load(ctr, __ATOMIC_RELAXED, __HIP_MEMORY_SCOPE_AGENT) < target) __builtin_amdgcn_s_sleep(4);
    }
    __syncthreads();
    __builtin_amdgcn_fence(__ATOMIC_ACQUIRE, "agent");
}
struct Args { const float* in[17]; float* out; unsigned char* ws; int ph_lo, ph_hi; };
constexpr int NPHASE = 9;

template <bool COOP>
__global__ void __launch_bounds__(512) mk_fwd(Args args) {
    extern __shared__ __attribute__((aligned(16))) unsigned char lds_raw[];
    LAS unsigned char* lds = (LAS unsigned char*)lds_raw;
    const int tid = threadIdx.x, lane = tid & 63, wave = __builtin_amdgcn_readfirstlane(tid >> 6);
    const int G = gridDim.x, bid = blockIdx.x;
    const int gw = bid * 8 + wave, NGW = G * 8;
    unsigned char* ws = args.ws; unsigned char* dob = (unsigned char*)args.out;
    const float* xp = args.in[0]; const float* xs = args.in[1];
    bf16_t* H = (bf16_t*)(dob + DO_H); bf16_t* QMLA = (bf16_t*)(dob + DO_QMLA); bf16_t* MN = (bf16_t*)(dob + DO_MN);
    f32x2* TABG = (f32x2*)(ws + WS_TABG); f32x2* TABM = (f32x2*)(ws + WS_TABM); float* GQP = (float*)(ws + WS_GQP); float* GKP = (float*)(ws + WS_GKP);
    const int lo = args.ph_lo, hi = args.ph_hi;
    __builtin_amdgcn_fence(__ATOMIC_ACQUIRE, "agent");
#ifndef ONLY
#define ONLY -1
#endif
#define IN(k) ((ONLY < 0 || ONLY == (k)) && lo <= (k) && (k) < hi)
    unsigned nbar = 0;
#define SEAM(k) do { if constexpr (COOP) { if (IN(k) && IN((k) + 1)) { ++nbar; grid_barrier((unsigned*)(ws + WS_BAR), nbar * (unsigned)G); } } } while (0)

    if (IN(0)) {
        constexpr int I0 = (NP1 / 64) * 32, I1 = 96 * 32, I2 = 24 * 8, I3 = 32 * 4, I4 = 32 * 32, I5 = 32 * 16, I6 = 32 * 32;
        constexpr int NITEMS = I0 + I1 + I2 + I3 + I4 + 3 * I5 + I6;
        for (int it = bid; it < NITEMS; it += G) {
            int r = it;
            if (r < I0) { transpose_item(args.in[5], 12608, 2048, (bf16_t*)(ws + WS_WIN), 0, r, lds, tid); continue; } r -= I0;
            if (r < I1) { transpose_item_fp8(args.in[5], 12608, 2048, ws + WS_WGL, 6464, r, lds, tid); continue; } r -= I1;
            if (r < I2) { transpose_item(args.in[7], 1536, 512, (bf16_t*)(ws + WS_WQB), 2, r, lds, tid); continue; } r -= I2;
            if (r < I3) { transpose_item(args.in[9], 2048, 256, (bf16_t*)(ws + WS_WKVB), 3, r, lds, tid); continue; } r -= I3;
            if (r < I4) { transpose_item(args.in[13], 2048, 2048, (bf16_t*)(ws + WS_WMKV), 4, r, lds, tid); continue; } r -= I4;
            if (r < 3 * I5) { const int i = r / I5; transpose_item(args.in[14] + (size_t)i * 1024 * 2048, 2048, 1024, (bf16_t*)(ws + WS_WBR) + (size_t)i * 2048 * 1024, 4, r - i * I5, lds, tid); continue; } r -= 3 * I5;
            transpose_item(args.in[15], 2048, 2048, (bf16_t*)(ws + WS_WOUT), 4, r, lds, tid);
        }
        for (int m = gw; m < T + MEMROWS; m += NGW) {
            if (m < T) { const float* xr = m < TP ? xp + (size_t)m * DM : xs + (size_t)(m - TP) * DM; rms_row_to_bf16(xr, args.in[4], H + (size_t)m * DM, ws + WS_H8 + (size_t)m * DM, lane); }
            else { const int mm = m - T; const float* xr = mm < 2048 ? args.in[2] + (size_t)mm * DM : args.in[3] + (size_t)(mm - 2048) * DM; rms_row_to_bf16(xr, args.in[12], MN + (size_t)mm * DM, nullptr, lane); }
        }
        for (int e = bid * 512 + tid; e < 4096 * 64 * 2 / 16; e += G * 512) ((u32x4*)(ws + WS_ZERO))[e] = (u32x4){0u, 0u, 0u, 0u};
        if (bid == 0) {
            for (int e = tid; e < 64 * 32; e += 512) { const int pos = e >> 5, i = e & 31; double f = 1.0; for (int k = 0; k < i; ++k) f *= 0.7498942093324559; const float ang = (float)pos * (float)f; float c, s; sincos_d(ang, c, s); TABG[e] = (f32x2){c, s}; }
            for (int e = tid; e < 64 * 16; e += 512) { const int pos = e >> 4, i = e & 15; double f = 1.0; for (int k = 0; k < i; ++k) f *= 0.5623413251903491; const float ang = (float)pos * (float)f; float c, s; sincos_d(ang, c, s); TABM[e] = (f32x2){c, s}; }
            if (tid < 128) { GQP[tid] = args.in[10][gperm_inv128(tid)]; GKP[tid] = args.in[11][gperm_inv128(tid)]; }
        }
    }
    if constexpr (COOP) { if (IN(0) && IN(1)) cg::this_grid().sync(); }

    if (IN(1)) {
        { pg8::Gemm g{H, (const bf16_t*)(ws + WS_WIN), 2048, 2048, T, NP1, 2048}; pg8::StaticOrder S; S.init(T, NP1, G, bid);
          pg8::EpiP1 E{ws}; pg8::gemm_phase(lds, g, S, E); }
        { pg8::Gemm g{MN, (const bf16_t*)(ws + WS_WMKV), 2048, 2048, MEMROWS, 2048, 2048}; pg8::StaticOrder S; S.init(MEMROWS, 2048, G, (bid + 128) % G);
          pg8::EpiSplit E{(bf16_t*)(ws + WS_KM), (bf16_t*)(ws + WS_VM), 1024}; pg8::gemm_phase(lds, g, S, E); }
    }
    SEAM(1);

    if (IN(2)) {
        bf16_t* CQ = (bf16_t*)(ws + WS_CQ); bf16_t* CKV = (bf16_t*)(ws + WS_CKV); bf16_t* KPE = (bf16_t*)(ws + WS_KPE); bf16_t* QG = (bf16_t*)(ws + WS_QG); bf16_t* KG = (bf16_t*)(ws + WS_KG);
        const float* gq = args.in[6]; const float* gkv = args.in[8];
        const int ga_ = lane >> 5, gi_ = lane & 31; const float gq1 = GQP[2 * lane], gq2 = GQP[2 * lane + 1], gk1 = GKP[2 * lane], gk2 = GKP[2 * lane + 1];
        const f32x4 g0q = *(const f32x4*)(gq + lane * 8), g1q = *(const f32x4*)(gq + lane * 8 + 4), g0k = *(const f32x4*)(gkv + lane * 4);
        for (int r = gw; r < T; r += NGW) {
            const int s = r & 4095, prow = s >> 6, pcol = s & 63;
            bf16_t* pq = CQ + (size_t)r * 512 + lane * 8; bf16_t* pk = CKV + (size_t)r * 256 + lane * 4; unsigned* pe = (unsigned*)(KPE + (size_t)r * 64) + (lane & 31);
            const u32x4 wq = *(const u32x4*)pq; const u32x2 wk = *(const u32x2*)pk; const unsigned we = *pe;
            unsigned wh[10];
#pragma unroll
            for (int h = 0; h < 10; ++h) wh[h] = *((h < 8 ? (const unsigned*)(QG + (size_t)r * 1024 + h * 128) : (const unsigned*)(KG + (size_t)r * 256 + (h - 8) * 128)) + lane);
            const f32x2 csm = TABM[(((lane >> 4) & 1) ? pcol : prow) * 16 + (lane & 15)]; const f32x2 cs = TABG[(ga_ ? pcol : prow) * 32 + gi_];
            { float x[8] = {bf_lo(wq.x), bf_hi(wq.x), bf_lo(wq.y), bf_hi(wq.y), bf_lo(wq.z), bf_hi(wq.z), bf_lo(wq.w), bf_hi(wq.w)};
              float ss = 0.f;
#pragma unroll
              for (int j = 0; j < 8; ++j) ss += x[j] * x[j];
              const float rstd = 1.0f / sqrtf(wave_sum(ss) * (1.f / 512) + EPS);
              u32x4 o; o.x = cvt_pk_bf16(x[0] * rstd * g0q[0], x[1] * rstd * g0q[1]); o.y = cvt_pk_bf16(x[2] * rstd * g0q[2], x[3] * rstd * g0q[3]); o.z = cvt_pk_bf16(x[4] * rstd * g1q[0], x[5] * rstd * g1q[1]); o.w = cvt_pk_bf16(x[6] * rstd * g1q[2], x[7] * rstd * g1q[3]);
              *(u32x4*)pq = o; }
            { float x[4] = {bf_lo(wk.x), bf_hi(wk.x), bf_lo(wk.y), bf_hi(wk.y)};
              const float ss = (x[0] * x[0] + x[1] * x[1]) + (x[2] * x[2] + x[3] * x[3]);
              const float rstd = 1.0f / sqrtf(wave_sum(ss) * (1.f / 256) + EPS);
              u32x2 o; o.x = cvt_pk_bf16(x[0] * rstd * g0k[0], x[1] * rstd * g0k[1]); o.y = cvt_pk_bf16(x[2] * rstd * g0k[2], x[3] * rstd * g0k[3]); *(u32x2*)pk = o; }
            if (lane < 32) { const float x1 = bf_lo(we), x2 = bf_hi(we); *pe = cvt_pk_bf16(x1 * csm[0] - x2 * csm[1], x2 * csm[0] + x1 * csm[1]); }
#pragma unroll
            for (int h = 0; h < 10; ++h) { float x1 = bf_lo(wh[h]), x2 = bf_hi(wh[h]); const float rstd = 1.0f / sqrtf(wave_sum(x1 * x1 + x2 * x2) * (1.f / 128) + EPS);
                x1 = x1 * rstd * (h < 8 ? gq1 : gk1); x2 = x2 * rstd * (h < 8 ? gq2 : gk2);
                *((h < 8 ? (unsigned*)(QG + (size_t)r * 1024 + h * 128) : (unsigned*)(KG + (size_t)r * 256 + (h - 8) * 128)) + lane) = cvt_pk_bf16(x1 * cs[0] - x2 * cs[1], x2 * cs[0] + x1 * cs[1]); }
        }
        const bf16_t* VM = (const bf16_t*)(ws + WS_VM); bf16_t* VMT = (bf16_t*)(ws + WS_VMT);
        for (int ln = gw; ln < 1024 * NBATCH * 4; ln += NGW) { const int c = ln / (NBATCH * 4), rem = ln - c * (NBATCH * 4); const int b = rem >> 2, seg = rem & 3;
            const int pos = seg * 64 + lane; const int key = (pos & ~31) + 16 * ((pos >> 2) & 1) + 4 * ((pos >> 3) & 3) + (pos & 3);
            VMT[(size_t)c * MEMROWS + b * 256 + pos] = VM[(size_t)(b * 256 + key) * 1024 + c]; }
    }
    SEAM(2);


    if (IN(3)) {
        { pg8::Gemm g{(const bf16_t*)(ws + WS_CQ), (const bf16_t*)(ws + WS_WQB), 512, 512, T, 1536, 512}; pg8::StaticOrder S; S.init(T, 1536, G, bid);
          pg8::EpiQ E{QMLA, TABM}; pg8::gemm_phase(lds, g, S, E); }
        { pg8::Gemm g{(const bf16_t*)(ws + WS_CKV), (const bf16_t*)(ws + WS_WKVB), 256, 256, T, 2048, 256}; pg8::StaticOrder S; S.init(T, 2048, G, bid);
          pg8::EpiSplit E{(bf16_t*)(ws + WS_KN), (bf16_t*)(ws + WS_VN), 1024}; pg8::gemm_phase(lds, g, S, E); }
    }
    SEAM(3);


    if (IN(4)) {
        bf16_t* Z = (bf16_t*)(ws + WS_Z);
        const int NU = NBATCH * 8 * 16;
#define DECODE_UNIT(u) int bh, qb; if (G == 256) { const int i_ = (u) >> 8, c_ = (u) & 255; qb = (c_ >> 3) & 15; bh = i_ * 16 + (c_ & 7) * 2 + (c_ >> 7); } else { bh = (u) >> 4; qb = (u) & 15; } \
        const int b = bh >> 3, h = bh & 7; const size_t r0 = (size_t)b * SEQ + qb * 256;
#ifndef SKIP_MLA
        for (int u = bid; u < NU; u += G) { DECODE_UNIT(u)
            att::attn_unit<64, 1536, 1024, 1024, 192>(QMLA + r0 * 1536 + h * 192, (const bf16_t*)(ws + WS_KN) + (size_t)b * SEQ * 1024 + h * 128, (const bf16_t*)(ws + WS_KPE) + (size_t)b * SEQ * 64,
                                                  (const bf16_t*)(ws + WS_VN) + (size_t)b * SEQ * 1024 + h * 128, Z + r0 * 3072 + h * 128, SEQ, (LAS char*)lds); }
#endif
#ifndef SKIP_GQA
        for (int u = bid; u < NU; u += G) { DECODE_UNIT(u)
            att::attn_unit<0, 1024, 256, 256, 128>((const bf16_t*)(ws + WS_QG) + r0 * 1024 + h * 128, (const bf16_t*)(ws + WS_KG) + (size_t)b * SEQ * 256 + (h >> 2) * 128, nullptr,
                                               (const bf16_t*)(ws + WS_VG) + (size_t)b * SEQ * 256 + (h >> 2) * 128, Z + r0 * 3072 + 1024 + h * 128, SEQ, (LAS char*)lds); }
#endif
#undef DECODE_UNIT
#ifndef SKIP_MEM
        for (int u = bid; u < NBATCH * 4 * 32; u += G) { const int bh = u >> 5, rb = u & 31;
            mem_attn_block((const bf16_t*)(ws + WS_QM), (const bf16_t*)(ws + WS_KM), (const bf16_t*)(ws + WS_VMT), Z, bh >> 2, bh & 3, rb, lds, tid); }
#endif
    }
    SEAM(4);


#ifdef PROBE_CHECK
    if (lo == 20) {
        unsigned* cnt = (unsigned*)(ws + WS_ZERO + 4096 * 64 * 2 - 32);
        { const unsigned sidx = (unsigned)(bid * 512 + tid); const int tok = (int)((sidx * 2654435761u >> 7) % 2560u), c = (int)((sidx * 40503u >> 2) & 1023u); const int b_ = tok >> 8, key = tok & 255; const int pos = (key & ~31) + 8 * ((key >> 2) & 3) + 4 * ((key >> 4) & 1) + (key & 3);
          const bf16_t a_ = ((const bf16_t*)(ws + WS_VMT))[(size_t)c * MEMROWS + b_ * 256 + pos], b2_ = ((const bf16_t*)(ws + WS_VM))[(size_t)tok * 1024 + c]; if (a_ != b2_) atomicAdd(cnt + ((c & 128) ? 2 : 3), 1u); }
        const int w = bid * 8 + wave; const int r = (int)(((long)w * 977 + 13) % T); const int b = r >> 12; const int br = PROBE_BR;
        const int h = w & (br == 2 ? 3 : 7);
        const bf16_t* Qp; const bf16_t* Kp; const bf16_t* Xp = nullptr; const bf16_t* Vp; int ldk, ldv, dk, nk; float scale;
        if (br == 0) { Qp = QMLA + (size_t)r * 1536 + h * 192; Kp = (const bf16_t*)(ws + WS_KN) + (size_t)b * SEQ * 1024 + h * 128; Xp = (const bf16_t*)(ws + WS_KPE) + (size_t)b * SEQ * 64; Vp = (const bf16_t*)(ws + WS_VN) + (size_t)b * SEQ * 1024 + h * 128; ldk = 1024; ldv = 1024; dk = 128; nk = 4096; scale = 0.07216878364870323f; }
        else if (br == 1) { Qp = (const bf16_t*)(ws + WS_QG) + (size_t)r * 1024 + h * 128; Kp = (const bf16_t*)(ws + WS_KG) + (size_t)b * SEQ * 256 + (h >> 2) * 128; Vp = (const bf16_t*)(ws + WS_VG) + (size_t)b * SEQ * 256 + (h >> 2) * 128; ldk = 256; ldv = 256; dk = 128; nk = 4096; scale = 0.08838834764831843f; }
        else { Qp = (const bf16_t*)(ws + WS_QM) + (size_t)r * 1024 + h * 256; Kp = (const bf16_t*)(ws + WS_KM) + (size_t)b * 256 * 1024 + h * 256; Vp = (const bf16_t*)(ws + WS_VM) + (size_t)b * 256 * 1024 + h * 256 + 128; ldk = 1024; ldv = 1024; dk = 256; nk = 256; scale = 0.0625f; }
        float p[64]; float m = -1e30f;
#pragma unroll
        for (int j = 0; j < 64; ++j) { const int key = lane + 64 * j; float sdot = -1e30f;
            if (key < nk) { sdot = 0.f; for (int d = 0; d < dk; ++d) sdot += __uint_as_float((unsigned)Qp[d] << 16) * __uint_as_float((unsigned)Kp[(size_t)key * ldk + d] << 16);
                if (Xp) for (int d = 0; d < 64; ++d) sdot += __uint_as_float((unsigned)Qp[128 + d] << 16) * __uint_as_float((unsigned)Xp[(size_t)key * 64 + d] << 16);
                sdot *= scale; }
            p[j] = sdot; m = fmaxf(m, sdot); }
#pragma unroll
        for (int o = 1; o < 64; o <<= 1) m = fmaxf(m, __shfl_xor(m, o));
        float l = 0.f;
#pragma unroll
        for (int j = 0; j < 64; ++j) { p[j] = (lane + 64 * j < nk) ? __expf(p[j] - m) : 0.f; l += p[j]; }
        l = wave_sum(l);
        int bad = 0;
        const int zc = br * 1024 + (br == 2 ? h * 256 + 128 : h * 128);
        for (int d = 0; d < 128; ++d) { float acc = 0.f;
#pragma unroll
            for (int j = 0; j < 64; ++j) { const int key = lane + 64 * j; if (key < nk) acc += p[j] * __uint_as_float((unsigned)Vp[(size_t)key * ldv + d] << 16); }
            acc = wave_sum(acc) / l;
            float zd = 0.f; const bf16_t* wz = (const bf16_t*)(ws + WS_WIN) + (size_t)(3584 + zc + d) * 2048;
            for (int k = lane; k < 2048; k += 64) zd += __uint_as_float((unsigned)H[(size_t)r * 2048 + k] << 16) * __uint_as_float((unsigned)wz[k] << 16);
            zd = wave_sum(zd); const float sz = zd / (1.f + __expf(-zd)); const float szb = __uint_as_float(cvt_pk_bf16(sz, 0.f) << 16);
#ifdef PROBE_NOZ
            const float uref = acc; (void)szb;
#else
            const float uref = acc * szb;
#endif
            const float um = __uint_as_float((unsigned)((const bf16_t*)(ws + WS_Z))[(size_t)r * 3072 + zc + d] << 16);
            if (fabsf(um - uref) > 0.02f * fabsf(uref) + 0.0003f) ++bad; }
        if (lane == 0) { atomicAdd(cnt + 0, 1u); if (bad > 0) atomicAdd(cnt + 1, 1u); }
    }
    if (lo == 21 && bid < 64) {
        unsigned* cnt = (unsigned*)(ws + WS_ZERO + 4096 * 64 * 2 - 32);
        const int w = bid * 8 + wave; const int r = (int)(((long)w * 977 + 13) % T), c = (w * 1543 + 11) % 6144;
        float gd = 0.f; const bf16_t* wg = (const bf16_t*)(ws + WS_WGL) + (size_t)c * 2048;
        for (int k = lane; k < 2048; k += 64) gd += __uint_as_float((unsigned)H[(size_t)r * 2048 + k] << 16) * __uint_as_float((unsigned)wg[k] << 16);
        gd = wave_sum(gd); const float gref = 1.f / (1.f + __expf(-gd)); const float gm = __uint_as_float((unsigned)((const bf16_t*)(ws + WS_GL))[(size_t)r * 6144 + c] << 16);
        if (lane == 0 && fabsf(gm - gref) > 0.005f) atomicAdd(cnt + 4, 1u);
    }
    if (lo == 22 && bid < 64) {
        unsigned* cnt = (unsigned*)(ws + WS_ZERO + 4096 * 64 * 2 - 32);
        const int w = bid * 8 + wave; const int r = (int)(((long)w * 977 + 13) % T), c = (w * 389 + 7) & 2047;
        const bf16_t* GLb = (const bf16_t*)(ws + WS_GL); const bf16_t* Zb = (const bf16_t*)(ws + WS_Z); const bf16_t* WBRb = (const bf16_t*)(ws + WS_WBR); const bf16_t* MG = (const bf16_t*)(ws + WS_MERGED);
        const bf16_t* WO = (const bf16_t*)(ws + WS_WOUT);
        float mref = 0.f;
        for (int i = 0; i < 3; ++i) { float d = 0.f; for (int k = lane; k < 1024; k += 64) d += __uint_as_float((unsigned)Zb[(size_t)r * 3072 + i * 1024 + k] << 16) * __uint_as_float((unsigned)WBRb[((size_t)i * 2048 + c) * 1024 + k] << 16);
            d = wave_sum(d); mref += d * __uint_as_float((unsigned)GLb[(size_t)r * 6144 + i * 2048 + c] << 16); }
        const float mm = __uint_as_float((unsigned)MG[(size_t)r * 2048 + c] << 16);
        float yd = 0.f; for (int k = lane; k < 2048; k += 64) yd += __uint_as_float((unsigned)MG[(size_t)r * 2048 + k] << 16) * __uint_as_float((unsigned)WO[(size_t)c * 2048 + k] << 16);
        yd = wave_sum(yd); const float* xr = r < TP ? xp + (size_t)r * DM : xs + (size_t)(r - TP) * DM; const float yref = xr[c] + yd; const float ym = args.out[(size_t)r * DM + c];
        if (lane == 0) {
            if (fabsf(mm - mref) > 0.015f * fabsf(mref) + 0.0003f) atomicAdd(cnt + 5, 1u);
            if (fabsf(ym - yref) > 0.001f) atomicAdd(cnt + 6, 1u); }
    }
#endif
    if (IN(5)) {
        for (int i = 0; i < 3; ++i) {
            pg8::Gemm g{(const bf16_t*)(ws + WS_H8), (const bf16_t*)(ws + WS_WGL) + (size_t)i * 2048 * 1024, 1024, 1024, T, 2048, 1024}; pg8::StaticOrder S; S.init(T, 2048, G, bid);
            pg8::EpiGL E{(bf16_t*)(ws + WS_GL) + i * 2048, 1.f / (H8_SCALE * W8_SCALE)}; pg8::gemm_phase<pg8::EpiGL, pg8::StaticOrder, true>(lds, g, S, E);
        }
    }
    if constexpr (COOP) { __syncthreads(); }

    if (IN(6)) {
#ifndef PROBE_ZERO
#define PROBE_ZERO -1
#endif
        for (int i = 0; i < 3; ++i) {
            if (i == PROBE_ZERO) continue;
            pg8::Gemm g{(const bf16_t*)(ws + WS_Z) + i * 1024, (const bf16_t*)(ws + WS_WBR) + (size_t)i * 2048 * 1024, 3072, 1024, T, 2048, 1024}; pg8::StaticOrder S; S.init(T, 2048, G, bid);
            pg8::EpiBR E{(const bf16_t*)(ws + WS_GL) + i * 2048, (bf16_t*)(ws + WS_MERGED), i == (PROBE_ZERO == 0 ? 1 : 0)}; pg8::gemm_phase(lds, g, S, E);
        }
    }
    SEAM(6);

    if (IN(7)) {
        pg8::Gemm g{(const bf16_t*)(ws + WS_MERGED), (const bf16_t*)(ws + WS_WOUT), 2048, 2048, T, 2048, 2048}; pg8::StaticOrder S; S.init(T, 2048, G, bid);
        pg8::EpiOut E{xp, xs, args.out, (float*)(ws + WS_SSQ)}; pg8::gemm_phase(lds, g, S, E);
    }
    SEAM(7);


#ifdef PROBE_SCAN
    if (lo == 30) {
        unsigned* cnt = (unsigned*)(ws + WS_ZERO + 4096 * 64 * 2 - 32);
        const size_t gt = (size_t)bid * 512 + tid, gn = (size_t)G * 512;
        unsigned f = 0;
        { const bf16_t* p = (const bf16_t*)(ws + WS_WIN); const size_t n = (WS_TABG - WS_WIN) / 2; for (size_t i = gt; i < n; i += gn) { const float v = __uint_as_float((unsigned)p[i] << 16); if (!(fabsf(v) < 0.5f)) f |= 1u; } }
        { const bf16_t* p = (const bf16_t*)(ws + WS_MERGED); const size_t n = (size_t)T * 2048; for (size_t i = gt; i < n; i += gn) { const float v = __uint_as_float((unsigned)p[i] << 16); if (!(fabsf(v) < 2.0f)) f |= 2u; } }
        { const bf16_t* p = (const bf16_t*)(ws + WS_Z); const size_t n = (size_t)T * 3072; for (size_t i = gt; i < n; i += gn) { const float v = __uint_as_float((unsigned)p[i] << 16); if (!(fabsf(v) < 4.0f)) f |= 4u; } }
        { const bf16_t* p = (const bf16_t*)(ws + WS_GL); const size_t n = (size_t)T * 6144; for (size_t i = gt; i < n; i += gn) { const float v = __uint_as_float((unsigned)p[i] << 16); if (!(v >= 0.f && v <= 1.f)) f |= 8u; } }
        if (f & 1u) atomicAdd(cnt + 1, 1u); if (f & 2u) atomicAdd(cnt + 2, 1u); if (f & 4u) atomicAdd(cnt + 3, 1u); if (f & 8u) atomicAdd(cnt + 4, 1u);
        if (tid == 0) atomicAdd(cnt + 0, 1u);
    }
#endif
#define PH_FINAL 8
    if (IN(PH_FINAL)) {
        const float* gf = args.in[16];
#if defined(PROBE_SCAN)
        const unsigned* cntp = (const unsigned*)(ws + WS_ZERO + 4096 * 64 * 2 - 32);
        unsigned nn[5];
        for (int q = 0; q < 5; ++q) nn[q] = __hip_atomic_load(cntp + q, __ATOMIC_RELAXED, __HIP_MEMORY_SCOPE_AGENT);
        const float pscale = 1.f + (nn[0] == (unsigned)G ? 0.05f : 0.f) + (nn[1] > 0u ? 0.1f : 0.f) + (nn[2] > 0u ? 0.2f : 0.f) + (nn[3] > 0u ? 0.4f : 0.f) + (nn[4] > 0u ? 0.8f : 0.f);
#elif defined(PROBE_CHECK)
        const unsigned* cntp = (const unsigned*)(ws + WS_ZERO + 4096 * 64 * 2 - 32);
        unsigned nn[7];
        for (int q = 0; q < 7; ++q) nn[q] = __hip_atomic_load(cntp + q, __ATOMIC_RELAXED, __HIP_MEMORY_SCOPE_AGENT);
        const float pscale = 1.f + (nn[0] == 2048u ? 0.05f : 0.f) + (float)nn[1] * 0.01f;
#else
        const float pscale = 1.f;
#endif
        for (int r = gw; r < T; r += NGW) {
            f32x4* orow = (f32x4*)(args.out + (size_t)r * DM);
            f32x4 v[8]; float sq = 0.f;
#pragma unroll
            for (int j = 0; j < 8; ++j) { v[j] = orow[lane + 64 * j]; sq += (v[j][0] * v[j][0] + v[j][1] * v[j][1]) + (v[j][2] * v[j][2] + v[j][3] * v[j][3]); }
#ifdef PROBE_NORSTD
            const float rstd = pscale + 0.f * wave_sum(sq);
#else
            const float rstd = pscale / sqrtf(wave_sum(sq) * (1.f / DM) + EPS);
#endif
#pragma unroll
            for (int j = 0; j < 8; ++j) {
#ifdef PROBE_NOGAIN
                const f32x4 gg = (f32x4){1.f, 1.f, 1.f, 1.f};
#else
                const f32x4 gg = ((const f32x4*)gf)[lane + 64 * j];
#endif
                f32x4 w; w[0] = v[j][0] * rstd * gg[0]; w[1] = v[j][1] * rstd * gg[1]; w[2] = v[j][2] * rstd * gg[2]; w[3] = v[j][3] * rstd * gg[3]; orow[lane + 64 * j] = w; }
        }
    }
    __builtin_amdgcn_fence(__ATOMIC_RELEASE, "agent");
#undef IN
#undef SEAM
}

extern "C" void kernel_launch(void* const* d_in, const int* in_sizes, int n_in, void* d_out, int out_size, void* d_ws, size_t ws_size, hipStream_t stream) {
    static int grid = 0;
    if (grid == 0) {
        if (n_in != 17 || out_size != T * DM || ws_size < WS_END) { fprintf(stderr, "kernel_launch: unexpected shapes: n_in %d out %d ws %zu (need %zu)\n", n_in, out_size, ws_size, (size_t)WS_END); grid = -1; return; }
        int dev = 0, cus = 0;
        if (hipGetDevice(&dev) != hipSuccess || hipDeviceGetAttribute(&cus, hipDeviceAttributeMultiprocessorCount, dev) != hipSuccess) { grid = -1; return; }
        if (hipFuncSetAttribute((const void*)mk_fwd<MK_COOP != 0>, hipFuncAttributeMaxDynamicSharedMemorySize, LDS_BYTES) != hipSuccess) { fprintf(stderr, "kernel_launch: hipFuncSetAttribute failed\n"); grid = -1; return; }
        int per_cu = 0;
        if (hipOccupancyMaxActiveBlocksPerMultiprocessor(&per_cu, (const void*)mk_fwd<MK_COOP != 0>, 512, LDS_BYTES) != hipSuccess || per_cu < 1) { fprintf(stderr, "kernel_launch: occupancy query says %d\n", per_cu); per_cu = 1; }
        (void)hipGetLastError();
        grid = cus;
    }
    if (grid < 0) return;
    Args a{};
    for (int i = 0; i < 17; ++i) a.in[i] = (const float*)d_in[i];
    a.out = (float*)d_out; a.ws = (unsigned char*)d_ws;
#if MK_COOP
    (void)hipMemsetAsync((char*)d_ws + WS_BAR, 0, 256, stream);
    a.ph_lo = 0; a.ph_hi = NPHASE;
    void* kargs[] = {&a};
    hipError_t e = hipLaunchCooperativeKernel((const void*)mk_fwd<true>, dim3(grid), dim3(512), kargs, LDS_BYTES, stream);
    if (e != hipSuccess) fprintf(stderr, "kernel_launch: cooperative launch failed: %s (grid %d)\n", hipGetErrorString(e), grid);
#else
#if defined(PROBE_SCAN)
    const int seq_[10] = {0, 1, 2, 3, 4, 5, 6, 7, 30, 8};
    for (int q = 0; q < 10; ++q) { a.ph_lo = seq_[q]; a.ph_hi = seq_[q] + 1; hipLaunchKernelGGL(mk_fwd<false>, dim3(grid), dim3(512), LDS_BYTES, stream, a); }
#elif defined(PROBE_CHECK)
    const int seq_[12] = {0, 1, 2, 3, 4, 20, 5, 21, 6, 7, 22, 8};
    for (int q = 0; q < 12; ++q) { a.ph_lo = seq_[q]; a.ph_hi = seq_[q] + 1; hipLaunchKernelGGL(mk_fwd<false>, dim3(grid), dim3(512), LDS_BYTES, stream, a); }
#else
    for (int p = 0; p < NPHASE; ++p) { a.ph_lo = p; a.ph_hi = p + 1; hipLaunchKernelGGL(mk_fwd<false>, dim3(grid), dim3(512), LDS_BYTES, stream, a); }
#endif
#endif
}
```
